# Optimizing an MI355X kernel written in HIP

```python
import jax, jax.numpy as jnp
from jax import lax
import numpy as np

D_MODEL = 1024
BATCH = 16
SEQ = 2048
DEPTH = 4

N_MIXERS = 2
N_Q_HEADS = 16
N_KV_HEADS = 4
HEAD_DIM = D_MODEL // N_Q_HEADS
GQA_GROUP = N_Q_HEADS // N_KV_HEADS
ATTN_WIDTH = N_Q_HEADS * HEAD_DIM
KV_WIDTH = N_KV_HEADS * HEAD_DIM
WINDOW = 128
BLOCK = 128
ROPE_THETA = 10000.0
CONV_WIDTH = 3
CONV_DIM = D_MODEL
A_IN_COLS = ATTN_WIDTH + 2 * KV_WIDTH + ATTN_WIDTH
B_IN_COLS = 4 * CONV_DIM
N_ATTN_LAYERS = (DEPTH + 1) // 2
N_CONV_LAYERS = DEPTH // 2
EPS = 1e-6
MASK_VALUE = -1e30

kernel_name = "hybrid_swa_sink_shortconv_encoder"


def rmsnorm(x, g):
    xf = x.astype(jnp.float32)
    y = xf * lax.rsqrt(jnp.mean(xf * xf, axis=-1, keepdims=True) + EPS)
    return (y * g.astype(jnp.float32)).astype(x.dtype)


def rope_tables(seq_len):
    inv_freq = ROPE_THETA ** (-jnp.arange(0, HEAD_DIM, 2, dtype=jnp.float32) / HEAD_DIM)
    ang = jnp.arange(seq_len, dtype=jnp.float32)[:, None] * inv_freq[None, :]
    return jnp.cos(ang)[:, None, :], jnp.sin(ang)[:, None, :]


def apply_rope(x, cos, sin):
    x1, x2 = jnp.split(x, 2, axis=-1)
    cos = cos.astype(x.dtype)
    sin = sin.astype(x.dtype)
    return jnp.concatenate([x1 * cos - x2 * sin, x2 * cos + x1 * sin], axis=-1)


def banded_gqa_sink_attention(q, k, v, sink):
    b, s, _, _ = q.shape
    nblk = s // BLOCK
    qb = q.reshape(b, nblk, BLOCK, N_KV_HEADS, GQA_GROUP, HEAD_DIM)

    def band(t):
        tp = jnp.pad(t, ((0, 0), (BLOCK, BLOCK), (0, 0), (0, 0)))
        tp = tp.reshape(b, nblk + 2, BLOCK, N_KV_HEADS, HEAD_DIM)
        return jnp.concatenate([tp[:, :-2], tp[:, 1:-1], tp[:, 2:]], axis=2)

    kb, vb = band(k), band(v)
    scores = jnp.einsum('bnqkgd,bnckd->bnkgqc', qb, kb,
                        preferred_element_type=jnp.float32) * (HEAD_DIM ** -0.5)
    qi = jnp.arange(BLOCK)[:, None]
    ci = jnp.arange(3 * BLOCK)[None, :]
    rel = ci - BLOCK - qi
    kpos = jnp.arange(nblk)[:, None, None] * BLOCK - BLOCK + ci[None]
    valid = (jnp.abs(rel) <= WINDOW)[None] & (kpos >= 0) & (kpos < s)
    scores = jnp.where(valid[None, :, None, None], scores, MASK_VALUE)

    sink_f = sink.astype(jnp.float32).reshape(1, 1, N_KV_HEADS, GQA_GROUP, 1)
    m = jnp.maximum(jnp.max(scores, axis=-1), sink_f)
    p = jnp.exp(scores - m[..., None])
    denom = jnp.sum(p, axis=-1) + jnp.exp(sink_f - m)
    out = jnp.einsum('bnkgqc,bnckd->bnqkgd', p.astype(v.dtype), vb,
                     preferred_element_type=jnp.float32)
    out = out / jnp.moveaxis(denom, -1, 2)[..., None]
    return out.reshape(b, s, ATTN_WIDTH).astype(q.dtype)


def attention_mixer(h, w_in, q_g, k_g, sink, w_out, cos, sin):
    b, s, _ = h.shape
    proj = h @ w_in
    q, k, v, gate = jnp.split(
        proj, [ATTN_WIDTH, ATTN_WIDTH + KV_WIDTH, ATTN_WIDTH + 2 * KV_WIDTH], axis=-1)
    q = apply_rope(rmsnorm(q.reshape(b, s, N_Q_HEADS, HEAD_DIM), q_g), cos, sin)
    k = apply_rope(rmsnorm(k.reshape(b, s, N_KV_HEADS, HEAD_DIM), k_g), cos, sin)
    v = v.reshape(b, s, N_KV_HEADS, HEAD_DIM)
    o = banded_gqa_sink_attention(q, k, v, sink)
    return (o * jax.nn.silu(gate)) @ w_out


def short_conv_mixer(h, w_in, conv_w, w_out):
    s = h.shape[1]
    bg, cg, u, gate = jnp.split(h @ w_in, 4, axis=-1)
    z = cg * u
    pad = CONV_WIDTH // 2
    zp = jnp.pad(z, ((0, 0), (pad, pad), (0, 0)))
    conv = sum(conv_w[j] * zp[:, j:j + s] for j in range(CONV_WIDTH))
    y = bg * conv
    return (y * jax.nn.silu(gate)) @ w_out


def setup_inputs(seed: int = 0) -> dict:
    key = jax.random.key(seed)
    ks = jax.random.split(key, 12)
    f32 = jnp.float32
    x = jax.random.normal(ks[0], (BATCH, SEQ, D_MODEL), f32)
    norm_g = 1.0 + 0.02 * jax.random.normal(ks[1], (DEPTH, D_MODEL), f32)
    a_w_in = jax.random.normal(ks[2], (N_ATTN_LAYERS, D_MODEL, A_IN_COLS), f32) * D_MODEL ** -0.5
    a_q_norm = 1.0 + 0.02 * jax.random.normal(ks[3], (N_ATTN_LAYERS, HEAD_DIM), f32)
    a_k_norm = 1.0 + 0.02 * jax.random.normal(ks[4], (N_ATTN_LAYERS, HEAD_DIM), f32)
    a_sink = 0.5 * jax.random.normal(ks[5], (N_ATTN_LAYERS, N_Q_HEADS), f32)
    a_w_out = jax.random.normal(ks[6], (N_ATTN_LAYERS, ATTN_WIDTH, D_MODEL), f32) * ATTN_WIDTH ** -0.5
    b_w_in = jax.random.normal(ks[7], (N_CONV_LAYERS, D_MODEL, B_IN_COLS), f32) * D_MODEL ** -0.5
    b_conv = jax.random.normal(ks[8], (N_CONV_LAYERS, CONV_WIDTH, CONV_DIM), f32) * CONV_WIDTH ** -0.5
    b_w_out = jax.random.normal(ks[9], (N_CONV_LAYERS, CONV_DIM, D_MODEL), f32) * CONV_DIM ** -0.5
    return {"x": x, "norm_g": norm_g, "a_w_in": a_w_in, "a_q_norm": a_q_norm,
            "a_k_norm": a_k_norm, "a_sink": a_sink, "a_w_out": a_w_out,
            "b_w_in": b_w_in, "b_conv": b_conv, "b_w_out": b_w_out}


def reference(x, norm_g, a_w_in, a_q_norm, a_k_norm, a_sink, a_w_out, b_w_in, b_conv, b_w_out):
    cos, sin = rope_tables(x.shape[1])
    for i in range(DEPTH):
        h = rmsnorm(x, norm_g[i])
        slot = i // N_MIXERS
        if i % N_MIXERS == 0:
            y = attention_mixer(h, a_w_in[slot], a_q_norm[slot], a_k_norm[slot],
                                a_sink[slot], a_w_out[slot], cos, sin)
        else:
            y = short_conv_mixer(h, b_w_in[slot], b_conv[slot], b_w_out[slot])
        x = x + y
    return x
```

```cpp
#include <hip/hip_runtime.h>
#include <hip/hip_cooperative_groups.h>
#include <cstdio>
#include <cstdint>
namespace cg = cooperative_groups;
namespace pg8 {
#define PG8_LAS __attribute__((address_space(3)))
typedef unsigned short bf16_t;
typedef short bf16x8 __attribute__((ext_vector_type(8)));
typedef float f32x4 __attribute__((ext_vector_type(4)));
typedef unsigned u32x4 __attribute__((ext_vector_type(4)));
constexpr int BM = 256, BK = 64, HALF = 128, HTB = HALF * BK * 2  , STAGE_BYTES = 8 * HTB, NXCD = 8, WGM = 8;

__host__ __device__ __forceinline__ int lds_byte(int r, int c) { const int st = (r >> 4) * 2 + (c >> 5), rr = r & 15, cc = c & 31, ob = rr * 64 + cc * 2; return st * 1024 + (ob ^ (((ob >> 9) & 1) << 5)); }
__host__ __device__ __forceinline__ void stage_rc(int b, int& R, int& C) { const int st = b / 1024, sb = b % 1024, swz = sb ^ (((sb >> 9) & 1) << 5); R = (st >> 1) * 16 + swz / 64; C = (st & 1) * 32 + (swz % 64) / 2; }
__host__ __device__ __forceinline__ int perm32(int rho) { const int n = rho >> 4, i = rho & 15; return 8 * (i >> 2) + 4 * n + (i & 3); }

struct Unit { int pm, pn; };
struct Gemm { const bf16_t* A; const bf16_t* Bt; int M, N, K; };

struct StaticOrder {
    int nM, nN, nwg, G, c;
    __host__ __device__ void init(int M, int N, int G_, int c_) { nM = M / BM; nN = N / BM; nwg = nM * nN; G = G_; c = c_; }
    __host__ __device__ bool next(int i, Unit& u) const {
        const long L = (long)i * G + c; if (L >= nwg) return false;
        int wgid = (int)L; { const int q = nwg / NXCD, r = nwg % NXCD, xcd = wgid % NXCD, off = wgid / NXCD; wgid = (xcd < r ? xcd * (q + 1) : r * (q + 1) + (xcd - r) * q) + off; }
        const int nig = WGM * nN, gid = wgid / nig, fm = gid * WGM, gsz = (nM - fm) < WGM ? (nM - fm) : WGM;
        u.pm = fm + ((wgid % nig) % gsz); u.pn = (wgid % nig) / gsz; return true;
    }
    __device__ __forceinline__ void a_ready(const Unit&) const {}
    __device__ __forceinline__ void done(const Unit&) const {}
};
__device__ __forceinline__ unsigned cvt_pk_bf16(float lo, float hi) { unsigned r; asm volatile("v_cvt_pk_bf16_f32 %0, %1, %2" : "=v"(r) : "v"(lo), "v"(hi)); return r; }
typedef float f32x2 __attribute__((ext_vector_type(2)));
template <class Epi, class Sched, bool ALIGN_EPI = false, bool SP2 = false, int A_AUX = 0>
__device__ __forceinline__ void gemm_phase(PG8_LAS unsigned char* lds, const Gemm g, const Sched& S, const Epi& E) {
    int tid_ = threadIdx.x; asm volatile("" : "+v"(tid_));
    const int tid = tid_, wid = __builtin_amdgcn_readfirstlane(tid >> 6), lane = tid & 63, wr = wid >> 2, wc = wid & 3, fr = lane & 15, fq = lane >> 4;
    const int K = g.K, nt = K / BK;
    unsigned voffA[2], voffB[2];
#pragma unroll
    for (int i = 0; i < 2; ++i) { int R, C; stage_rc(tid * 16 + i * 8192, R, C); const int Rb = Epi::PERM ? ((R & ~31) + perm32(R & 31)) : R;
        voffA[i] = (unsigned)(R * K + C) * 2u; voffB[i] = (unsigned)(Rb * K + C) * 2u; }
    const size_t kstep = (size_t)(BK * 2);
    const size_t hstep = (size_t)HALF * K * 2;
    const size_t tstep = 2 * hstep;
    const unsigned ldsw = (unsigned)wid * 1024u;
    const int aoff = lds_byte(wr * 64 + fr, fq * 8), boff = lds_byte(wc * 32 + fr, fq * 8);
#define PG8_SA(b, h) (((b) * 2 + (h)) * HTB)
#define PG8_SB(b, h) ((4 + (b) * 2 + (h)) * HTB)
#define PG8_STAGE(bufoff, gbase, voff) do { _Pragma("unroll") for (int _i = 0; _i < 2; ++_i) \
        __builtin_amdgcn_global_load_lds((const unsigned*)((const char*)(gbase) + (voff)[_i]), (PG8_LAS unsigned*)(lds + (bufoff) + ldsw + _i * 8192), 16, 0, 0); } while (0)
#define PG8_STAGE_A(bufoff, gbase, voff) do { _Pragma("unroll") for (int _i = 0; _i < 2; ++_i) \
        __builtin_amdgcn_global_load_lds((const unsigned*)((const char*)(gbase) + (voff)[_i]), (PG8_LAS unsigned*)(lds + (bufoff) + ldsw + _i * 8192), 16, 0, A_AUX); } while (0)
#define PG8_LDA(dst, b, h) do { _Pragma("unroll") for (int m = 0; m < 4; ++m) _Pragma("unroll") for (int k = 0; k < 2; ++k) dst[m][k] = *(const PG8_LAS bf16x8*)(lds + PG8_SA(b, h) + aoff + m * 2048 + k * 1024); } while (0)
#define PG8_LDB(dst, b, h) do { _Pragma("unroll") for (int n = 0; n < 2; ++n) _Pragma("unroll") for (int k = 0; k < 2; ++k) dst[n][k] = *(const PG8_LAS bf16x8*)(lds + PG8_SB(b, h) + boff + n * 2048 + k * 1024); } while (0)
#define PG8_MMA(ai, bj, At, Bt) do { __builtin_amdgcn_s_setprio(1); _Pragma("unroll") for (int m = 0; m < 4; ++m) _Pragma("unroll") for (int n = 0; n < 2; ++n) _Pragma("unroll") for (int k = 0; k < 2; ++k) \
        acc[ai][bj][m][n] = __builtin_amdgcn_mfma_f32_16x16x32_bf16(Bt[n][k], At[m][k], acc[ai][bj][m][n], 0, 0, 0); __builtin_amdgcn_s_setprio(0); } while (0)
#define PG8_WAIT_V(n) asm volatile("s_waitcnt vmcnt(" #n ")" ::: "memory")
#define PG8_WAIT_L(n) asm volatile("s_waitcnt lgkmcnt(" #n ")" ::: "memory")
#define PG8_BAR __builtin_amdgcn_s_barrier()
#define PG8_SCHED __builtin_amdgcn_sched_barrier(0)
    Unit cur, nxt; int ui = 0;
    if (!S.next(0, cur)) return;
    f32x4 acc[2][2][4][2];
#pragma unroll
    for (int a = 0; a < 2; ++a)
#pragma unroll
        for (int b = 0; b < 2; ++b)
#pragma unroll
            for (int m = 0; m < 4; ++m)
#pragma unroll
                for (int n = 0; n < 2; ++n) acc[a][b][m][n] = (f32x4){0.f, 0.f, 0.f, 0.f};
    bf16x8 At[4][2], B0[2][2], B1[2][2];
    const char* cA = (const char*)g.A + (size_t)cur.pm * tstep; const char* cB = (const char*)g.Bt + (size_t)cur.pn * tstep;
    S.a_ready(cur);
    if constexpr (SP2) {
        PG8_STAGE(PG8_SB(0, 0), cB, voffB); PG8_STAGE(PG8_SB(0, 1), cB + hstep, voffB); PG8_STAGE_A(PG8_SA(0, 0), cA, voffA); PG8_STAGE_A(PG8_SA(0, 1), cA + hstep, voffA);
        if (wr == 1) PG8_BAR;
        PG8_WAIT_V(2); PG8_BAR;
        PG8_STAGE(PG8_SB(1, 0), cB + kstep, voffB); PG8_STAGE_A(PG8_SA(1, 0), cA + kstep, voffA); PG8_STAGE(PG8_SB(1, 1), cB + hstep + kstep, voffB);
        PG8_WAIT_V(6); PG8_BAR;
    } else {
        PG8_STAGE(PG8_SB(0, 0), cB, voffB); PG8_STAGE_A(PG8_SA(0, 0), cA, voffA); PG8_STAGE(PG8_SB(0, 1), cB + hstep, voffB); PG8_STAGE_A(PG8_SA(0, 1), cA + hstep, voffA);
        if (wr == 1) PG8_BAR;
        PG8_WAIT_V(4); PG8_BAR;
        PG8_STAGE(PG8_SB(1, 0), cB + kstep, voffB); PG8_STAGE_A(PG8_SA(1, 0), cA + kstep, voffA); PG8_STAGE(PG8_SB(1, 1), cB + hstep + kstep, voffB);
        PG8_WAIT_V(6); PG8_BAR;
    }
    for (;;) {
        const bool has_next = S.next(ui + 1, nxt);
        const char* nA = has_next ? (const char*)g.A + (size_t)nxt.pm * tstep : cA; const char* nB = has_next ? (const char*)g.Bt + (size_t)nxt.pn * tstep : cB;
        for (int t = 0; t < nt; t += 2) {
            const bool last = (t == nt - 2);
            const char* a1 = cA + (size_t)(t + 1) * kstep;
            const char* a2 = last ? nA : cA + (size_t)(t + 2) * kstep; const char* b2 = last ? nB : cB + (size_t)(t + 2) * kstep;
            const char* a3 = a2 + kstep; const char* b3 = b2 + kstep;
            if (last && has_next) S.a_ready(nxt);
            if constexpr (SP2) {
            PG8_LDB(B0, 0, 0); PG8_LDB(B1, 0, 1); PG8_SCHED; PG8_LDA(At, 0, 0); PG8_STAGE_A(PG8_SA(1, 1), a1 + hstep, voffA);
            PG8_WAIT_V(8); PG8_WAIT_L(0); PG8_BAR; PG8_MMA(0, 0, At, B0); PG8_MMA(0, 1, At, B1); PG8_BAR; PG8_SCHED;
            PG8_LDA(At, 0, 1); PG8_STAGE(PG8_SB(0, 0), b2, voffB); PG8_STAGE(PG8_SB(0, 1), b2 + hstep, voffB); PG8_STAGE_A(PG8_SA(0, 0), a2, voffA);
            PG8_WAIT_V(8); PG8_WAIT_L(0); PG8_BAR; PG8_MMA(1, 0, At, B0); PG8_MMA(1, 1, At, B1); PG8_BAR; PG8_SCHED;
            PG8_LDB(B0, 1, 0); PG8_LDB(B1, 1, 1); PG8_SCHED; PG8_LDA(At, 1, 0); PG8_STAGE_A(PG8_SA(0, 1), a2 + hstep, voffA);
            PG8_WAIT_V(8); PG8_WAIT_L(0); PG8_BAR; PG8_MMA(0, 0, At, B0); PG8_MMA(0, 1, At, B1); PG8_BAR; PG8_SCHED;
            PG8_LDA(At, 1, 1); PG8_STAGE(PG8_SB(1, 0), b3, voffB); PG8_STAGE(PG8_SB(1, 1), b3 + hstep, voffB); PG8_STAGE_A(PG8_SA(1, 0), a3, voffA);
            PG8_WAIT_V(8); PG8_WAIT_L(0); PG8_BAR; PG8_MMA(1, 0, At, B0); PG8_MMA(1, 1, At, B1); PG8_BAR; PG8_SCHED;
            } else {
            PG8_LDB(B0, 0, 0); PG8_SCHED; PG8_LDA(At, 0, 0); PG8_STAGE_A(PG8_SA(1, 1), a1 + hstep, voffA);
            PG8_WAIT_L(8); PG8_BAR; PG8_WAIT_L(0); PG8_MMA(0, 0, At, B0); PG8_BAR; PG8_SCHED;
            PG8_LDB(B1, 0, 1); PG8_STAGE(PG8_SB(0, 0), b2, voffB);
            PG8_BAR; PG8_WAIT_L(0); PG8_MMA(0, 1, At, B1); PG8_BAR;
            PG8_LDA(At, 0, 1); PG8_STAGE_A(PG8_SA(0, 0), a2, voffA);
            PG8_BAR; PG8_WAIT_L(0); PG8_MMA(1, 0, At, B0); PG8_BAR; PG8_SCHED;
            PG8_STAGE(PG8_SB(0, 1), b2 + hstep, voffB);
            PG8_WAIT_V(6); PG8_BAR; PG8_MMA(1, 1, At, B1); PG8_BAR;
            PG8_LDB(B0, 1, 0); PG8_SCHED; PG8_LDA(At, 1, 0); PG8_STAGE_A(PG8_SA(0, 1), a2 + hstep, voffA);
            PG8_WAIT_L(8); PG8_BAR; PG8_WAIT_L(0); PG8_MMA(0, 0, At, B0); PG8_BAR; PG8_SCHED;
            PG8_LDB(B1, 1, 1); PG8_STAGE(PG8_SB(1, 0), b3, voffB);
            PG8_BAR; PG8_WAIT_L(0); PG8_MMA(0, 1, At, B1); PG8_BAR;
            PG8_LDA(At, 1, 1); PG8_STAGE_A(PG8_SA(1, 0), a3, voffA);
            PG8_BAR; PG8_WAIT_L(0); PG8_MMA(1, 0, At, B0); PG8_BAR; PG8_SCHED;
            PG8_STAGE(PG8_SB(1, 1), b3 + hstep, voffB);
            PG8_WAIT_V(6); PG8_BAR; PG8_MMA(1, 1, At, B1); PG8_BAR;
            }
        }
        if constexpr (ALIGN_EPI) { if (wr == 0) PG8_BAR; }
        if constexpr (!Epi::AFTER_DRAIN) { E(acc, cur, wr, wc, fr, fq); S.done(cur); }
        if (!has_next) break;
#pragma unroll
        for (int a = 0; a < 2; ++a)
#pragma unroll
            for (int b = 0; b < 2; ++b)
#pragma unroll
                for (int m = 0; m < 4; ++m)
#pragma unroll
                    for (int n = 0; n < 2; ++n) acc[a][b][m][n] = (f32x4){0.f, 0.f, 0.f, 0.f};
        cur = nxt; cA = nA; cB = nB; ++ui;
        if constexpr (ALIGN_EPI) { if (wr == 1) PG8_BAR; }
    }
    PG8_WAIT_V(0);
    if constexpr (!ALIGN_EPI) { if (wr == 0) PG8_BAR; }
    PG8_BAR;
    if constexpr (Epi::AFTER_DRAIN) { E.fused(acc, cur, wr, wc, fr, fq, lds, wid, lane); S.done(cur); }
#undef PG8_SA
#undef PG8_SB
#undef PG8_STAGE
#undef PG8_STAGE_A
#undef PG8_LDA
#undef PG8_LDB
#undef PG8_MMA
#undef PG8_WAIT_V
#undef PG8_WAIT_L
#undef PG8_BAR
#undef PG8_SCHED
}
}

#ifndef OUT_A_AUX
#define OUT_A_AUX 0
#endif
#ifndef KV_AUX
#define KV_AUX 2
#endif
constexpr int BATCH = 16, SEQ = 2048, DM = 1024, MTOK = BATCH * SEQ;
constexpr int A_IN = 2560, B_IN = 4096;
constexpr float LOG2E = 1.4426950408889634f;
constexpr float QSCALE = 0.125f * LOG2E;
constexpr float NORM_EPS = 1e-6f;

#define LAS __attribute__((address_space(3)))
typedef float v4f __attribute__((ext_vector_type(4)));
typedef unsigned v4u __attribute__((ext_vector_type(4)));
typedef unsigned v2u __attribute__((ext_vector_type(2)));
typedef short s8x __attribute__((ext_vector_type(8)));
typedef float v16f __attribute__((ext_vector_type(16)));
typedef unsigned short bf16_t;

__device__ __forceinline__ float bf_lo(unsigned w) { return __uint_as_float(w << 16); }
__device__ __forceinline__ float bf_hi(unsigned w) { return __uint_as_float(w & 0xffff0000u); }
__device__ __forceinline__ float silu_f(float x) { return x * __builtin_amdgcn_rcpf(1.f + __builtin_amdgcn_exp2f(-x * LOG2E)); }
__device__ __forceinline__ unsigned pk_bf16(float lo, float hi) { return pg8::cvt_pk_bf16(lo, hi); }

namespace pg8 {
typedef unsigned u32x2 __attribute__((ext_vector_type(2)));
typedef _Float16 h16x8 __attribute__((ext_vector_type(8)));
__device__ __forceinline__ float row_rstd(const float* ss, int row) {
    const f32x4* p = (const f32x4*)(ss + (size_t)row * 16);
    const f32x4 a = p[0], b = p[1], c = p[2], d = p[3];
    const float s = (((a[0] + a[1]) + (a[2] + a[3])) + ((b[0] + b[1]) + (b[2] + b[3]))) + (((c[0] + c[1]) + (c[2] + c[3])) + ((d[0] + d[1]) + (d[2] + d[3])));
    return __builtin_amdgcn_rsqf(s * (1.f / 1024.f) + NORM_EPS);
}
struct RstdTab { const PG8_LAS float* tab; int pm0, pm1; const float* ss;
    __device__ __forceinline__ float get(int pm, int rl) const { return (pm == pm0) ? tab[rl] : (pm == pm1) ? tab[256 + rl] : row_rstd(ss, pm * 256 + rl); } };
struct EpiAin {
    static constexpr bool PERM = true, AFTER_DRAIN = false;
    bf16_t *Q, *Kb, *Vb, *Gt; RstdTab rt; const PG8_LAS float *gq, *gk; const _Float16* csT;
    __device__ __forceinline__ void operator()(const f32x4 (&acc)[2][2][4][2], const Unit& u, int wr, int wc, int fr, int fq) const {
        const int pn = u.pn;
        if (pn <= 4) {
            const bool isq = pn < 4;
            const PG8_LAS float* gp = isq ? gq : gk;
            const float osc = isq ? QSCALE : 1.f;
            f32x4 gv[2][2];
#pragma unroll
            for (int bj = 0; bj < 2; ++bj)
#pragma unroll
                for (int n = 0; n < 2; ++n) gv[bj][n] = *(const PG8_LAS f32x4*)(gp + 32 * bj + 8 * fq + 4 * n);
#pragma unroll
            for (int ai = 0; ai < 2; ++ai) {
                const int row0 = u.pm * BM + ai * HALF + wr * 64 + fr;
                h16x8 cw[4], sw[4];
#pragma unroll
                for (int m = 0; m < 4; ++m) { const h16x8* tp = (const h16x8*)(csT + ((size_t)((row0 + 16 * m) & (SEQ - 1)) * 4 + fq) * 16); cw[m] = tp[0]; sw[m] = tp[1]; }
#pragma unroll
                for (int m = 0; m < 4; ++m) {
                    const int row = row0 + 16 * m;
                    const float rstd = rt.get(u.pm, ai * HALF + wr * 64 + m * 16 + fr);
                    f32x4 v[2][2]; float sq = 0.f;
#pragma unroll
                    for (int bj = 0; bj < 2; ++bj)
#pragma unroll
                        for (int n = 0; n < 2; ++n) { v[bj][n] = acc[ai][bj][m][n] * rstd; const f32x4 t2 = v[bj][n] * v[bj][n]; sq += (t2[0] + t2[1]) + (t2[2] + t2[3]); }
                    sq += __shfl_xor(sq, 16); sq += __shfl_xor(sq, 32);
                    const float rn = __builtin_amdgcn_rsqf(sq * (1.f / 64.f) + NORM_EPS);
                    const int t = row & (SEQ - 1);
                    u32x4 w0, w1;
#pragma unroll
                    for (int n = 0; n < 2; ++n) {
                        const f32x4 cs = {(float)cw[m][4 * n], (float)cw[m][4 * n + 1], (float)cw[m][4 * n + 2], (float)cw[m][4 * n + 3]}, sn = {(float)sw[m][4 * n], (float)sw[m][4 * n + 1], (float)sw[m][4 * n + 2], (float)sw[m][4 * n + 3]};
                        const f32x4 y1 = v[0][n] * rn * gv[0][n], y2 = v[1][n] * rn * gv[1][n];
                        const f32x4 o1 = (y1 * cs - y2 * sn) * osc, o2 = (y2 * cs + y1 * sn) * osc;
                        w0[2 * n] = cvt_pk_bf16(o1[0], o1[1]); w0[2 * n + 1] = cvt_pk_bf16(o1[2], o1[3]);
                        w1[2 * n] = cvt_pk_bf16(o2[0], o2[1]); w1[2 * n + 1] = cvt_pk_bf16(o2[2], o2[3]);
                    }
                    if (isq) { bf16_t* p = Q + ((size_t)(row >> 5) * 16 + (4 * pn + wc)) * 2048 + (row & 31) * 8;
                        *(u32x4*)(p + fq * 256) = w0; *(u32x4*)(p + (4 + fq) * 256) = w1; }
                    else {
                        const int b = row >> 11; bf16_t* p = Kb + (size_t)((b * 4 + wc) * 32 + (t >> 6)) * 4096 + (t & 63) * 8;
                        *(u32x4*)(p + fq * 512) = w0; *(u32x4*)(p + (4 + fq) * 512) = w1;
                    }
                }
            }
        } else if (pn == 5) {
#pragma unroll
            for (int ai = 0; ai < 2; ++ai)
#pragma unroll
                for (int m = 0; m < 4; ++m) {
                    const int row = u.pm * BM + ai * HALF + wr * 64 + m * 16 + fr;
                    const float rstd = rt.get(u.pm, ai * HALF + wr * 64 + m * 16 + fr);
                    const int t = row & (SEQ - 1), b = row >> 11;
                    bf16_t* p = Vb + (size_t)((b * 4 + wc) * 32 + (t >> 6)) * 4096 + ((t & 63) >> 3) * 256 + (t & 7) * 32 + 8 * fq;
#pragma unroll
                    for (int bj = 0; bj < 2; ++bj) { const f32x4 a = acc[ai][bj][m][0] * rstd, c = acc[ai][bj][m][1] * rstd;
                        u32x4 w; w.x = cvt_pk_bf16(a[0], a[1]); w.y = cvt_pk_bf16(a[2], a[3]); w.z = cvt_pk_bf16(c[0], c[1]); w.w = cvt_pk_bf16(c[2], c[3]);
                        *(u32x4*)(p + bj * 2048) = w; }
                }
        } else {
#pragma unroll
            for (int ai = 0; ai < 2; ++ai)
#pragma unroll
                for (int m = 0; m < 4; ++m) {
                    const int row = u.pm * BM + ai * HALF + wr * 64 + m * 16 + fr;
                    const float rstd = rt.get(u.pm, ai * HALF + wr * 64 + m * 16 + fr);
                    bf16_t* p = Gt + ((size_t)(row >> 5) * 16 + (4 * (pn - 6) + wc)) * 2048 + (row & 31) * 8;
#pragma unroll
                    for (int bj = 0; bj < 2; ++bj) { const f32x4 a = acc[ai][bj][m][0] * rstd, c = acc[ai][bj][m][1] * rstd;
                        u32x4 w; w.x = cvt_pk_bf16(a[0], a[1]); w.y = cvt_pk_bf16(a[2], a[3]); w.z = cvt_pk_bf16(c[0], c[1]); w.w = cvt_pk_bf16(c[2], c[3]);
                        *(u32x4*)(p + (bj * 4 + fq) * 256) = w; }
                }
        }
    }
};
struct EpiBin {
    static constexpr bool PERM = true, AFTER_DRAIN = false;
    bf16_t *Y, *ZH, *CH; RstdTab rt; const PG8_LAS float* cw; float* YP;
    __device__ __forceinline__ void operator()(const f32x4 (&acc)[2][2][4][2], const Unit& u, int wr, int wc, int fr, int fq) const {
        const int ch = u.pn * 64 + wc * 16 + fq * 4, lane = fq * 16 + fr;
        const f32x4 w0 = *(const PG8_LAS f32x4*)(cw + ch), w1 = *(const PG8_LAS f32x4*)(cw + 1024 + ch), w2 = *(const PG8_LAS f32x4*)(cw + 2048 + ch);
        const int srcp = (fr == 0) ? lane + 15 : lane - 1, srcn = (fr == 15) ? lane - 15 : lane + 1;
#pragma unroll
        for (int ai = 0; ai < 2; ++ai) {
            f32x4 z[4], s[4];
#pragma unroll
            for (int m = 0; m < 4; ++m) {
                const int row = u.pm * BM + ai * HALF + wr * 64 + m * 16 + fr;
                const float rstd = rt.get(u.pm, ai * HALF + wr * 64 + m * 16 + fr);
                const f32x4 bg = acc[ai][0][m][0] * rstd, cgv = acc[ai][0][m][1] * rstd, uv = acc[ai][1][m][0] * rstd, gt = acc[ai][1][m][1] * rstd;
                z[m] = cgv * uv;
#pragma unroll
                for (int i = 0; i < 4; ++i) s[m][i] = bg[i] * silu_f(gt[i]);
            }
            const int g2 = ((u.pm * BM + ai * HALF + wr * 64) >> 6) * 2;
#pragma unroll
            for (int m = 0; m < 4; ++m) {
                const int row = u.pm * BM + ai * HALF + wr * 64 + m * 16 + fr;
                f32x4 zp, zn;
#pragma unroll
                for (int i = 0; i < 4; ++i) {
                    const float sp = (m > 0 && fr == 15) ? z[m > 0 ? m - 1 : 0][i] : z[m][i];
                    const float a = __shfl(sp, srcp);
                    zp[i] = (m == 0 && fr == 0) ? 0.f : a;
                    const float sn = (m < 3 && fr == 0) ? z[m < 3 ? m + 1 : 3][i] : z[m][i];
                    const float b = __shfl(sn, srcn);
                    zn[i] = (m == 3 && fr == 15) ? 0.f : b;
                }
                const f32x4 y = s[m] * (w0 * zp + w1 * z[m] + w2 * zn);
                u32x2 wy; wy.x = cvt_pk_bf16(y[0], y[1]); wy.y = cvt_pk_bf16(y[2], y[3]);
                *(u32x2*)(Y + (size_t)row * 1024 + ch) = wy;
                if (m == 0 && fr == 0) { const f32x4 c = s[0] * w0; u32x2 a, b; a.x = cvt_pk_bf16(z[0][0], z[0][1]); a.y = cvt_pk_bf16(z[0][2], z[0][3]); b.x = cvt_pk_bf16(c[0], c[1]); b.y = cvt_pk_bf16(c[2], c[3]);
                    *(u32x2*)(ZH + (size_t)g2 * 1024 + ch) = a; *(u32x2*)(CH + (size_t)g2 * 1024 + ch) = b; *(f32x4*)(YP + (size_t)g2 * 1024 + ch) = y; }
                if (m == 3 && fr == 15) { const f32x4 c = s[3] * w2; u32x2 a, b; a.x = cvt_pk_bf16(z[3][0], z[3][1]); a.y = cvt_pk_bf16(z[3][2], z[3][3]); b.x = cvt_pk_bf16(c[0], c[1]); b.y = cvt_pk_bf16(c[2], c[3]);
                    *(u32x2*)(ZH + (size_t)(g2 + 1) * 1024 + ch) = a; *(u32x2*)(CH + (size_t)(g2 + 1) * 1024 + ch) = b; *(f32x4*)(YP + (size_t)(g2 + 1) * 1024 + ch) = y; }
            }
        }
    }
};
struct EpiOut {
    static constexpr bool PERM = true, AFTER_DRAIN = false;
    bf16_t* xb; float* ss; float* fout;
    __device__ __forceinline__ void operator()(const f32x4 (&acc)[2][2][4][2], const Unit& u, int wr, int wc, int fr, int fq) const {
#pragma unroll
        for (int ai = 0; ai < 2; ++ai) {
            const size_t off0 = (size_t)(u.pm * BM + ai * HALF + wr * 64 + fr) * 1024 + u.pn * BM + wc * 32 + 8 * fq;
            u32x4 xw[4][2];
#pragma unroll
            for (int m = 0; m < 4; ++m)
#pragma unroll
                for (int bj = 0; bj < 2; ++bj) xw[m][bj] = *(const u32x4*)(xb + off0 + (size_t)m * 16 * 1024 + bj * HALF);
#pragma unroll
            for (int m = 0; m < 4; ++m) {
                const int row = u.pm * BM + ai * HALF + wr * 64 + m * 16 + fr;
                const size_t off = off0 + (size_t)m * 16 * 1024;
                float sq = 0.f;
#pragma unroll
                for (int bj = 0; bj < 2; ++bj) {
                    const f32x4 x0 = {bf_lo(xw[m][bj].x), bf_hi(xw[m][bj].x), bf_lo(xw[m][bj].y), bf_hi(xw[m][bj].y)}, x1 = {bf_lo(xw[m][bj].z), bf_hi(xw[m][bj].z), bf_lo(xw[m][bj].w), bf_hi(xw[m][bj].w)};
                    const f32x4 o0 = x0 + acc[ai][bj][m][0], o1 = x1 + acc[ai][bj][m][1];
                    if (fout) { __builtin_nontemporal_store(o0, (f32x4*)(fout + off + bj * HALF)); __builtin_nontemporal_store(o1, (f32x4*)(fout + off + bj * HALF + 4)); }
                    else {
                        u32x4 w; w.x = cvt_pk_bf16(o0[0], o0[1]); w.y = cvt_pk_bf16(o0[2], o0[3]); w.z = cvt_pk_bf16(o1[0], o1[1]); w.w = cvt_pk_bf16(o1[2], o1[3]);
                        *(u32x4*)(xb + off + bj * HALF) = w;
                        const f32x4 q0 = o0 * o0, q1 = o1 * o1; sq += ((q0[0] + q0[1]) + (q0[2] + q0[3])) + ((q1[0] + q1[1]) + (q1[2] + q1[3]));
                    }
                }
                if (!fout) { sq += __shfl_xor(sq, 16); sq += __shfl_xor(sq, 32); if (fq == 0) ss[(size_t)row * 16 + u.pn * 4 + wc] = sq; }
            }
        }
    }
};
}

typedef LAS const char* lds_cptr;
typedef short v4i16_t __attribute__((ext_vector_type(4)));
__device__ __forceinline__ v4i16_t vtr(lds_cptr p) { return __builtin_amdgcn_ds_read_tr16_b64_v4i16((LAS v4i16_t*)p); }
#define MFMA32(a, b, c) __builtin_amdgcn_mfma_f32_32x32x16_bf16((a), (b), (c), 0, 0, 0)

__device__ __forceinline__ void attn_dma_block(LAS unsigned char* lds, const bf16_t* __restrict__ Kg, const bf16_t* __restrict__ Vg, int bkh, int blk, int wid, int lane) {
    const int slot = blk & 3;
#pragma unroll
    for (int t = 0; t < 2; ++t) {
        const size_t goff = (size_t)(bkh * 32 + 2 * blk + t) * 4096 + wid * 512 + lane * 8;
        LAS unsigned char* kd = lds + slot * 16384 + t * 8192 + wid * 1024;
        __builtin_amdgcn_global_load_lds((const unsigned*)(Kg + goff), (LAS unsigned*)kd, 16, 0, KV_AUX);
        __builtin_amdgcn_global_load_lds((const unsigned*)(Vg + goff), (LAS unsigned*)(kd + 65536), 16, 0, KV_AUX);
    }
}
__device__ __forceinline__ void attn_phase(LAS unsigned char* lds, const bf16_t* __restrict__ Q, const bf16_t* __restrict__ Kg, const bf16_t* __restrict__ Vg,
                                           const bf16_t* __restrict__ Gt, bf16_t* __restrict__ OG, const float* __restrict__ sink, float shift2, int c0, int G) {
    int tid_ = threadIdx.x; asm volatile("" : "+v"(tid_));
    const int tid = tid_, lane = tid & 63, wid = __builtin_amdgcn_readfirstlane(tid >> 6), r = lane & 31, h = lane >> 5;
    const int par = wid & 1, gh = wid >> 1, qoff = par * 64;
    const int voff = (4 * h + ((lane & 15) >> 2)) * 64 + ((lane >> 4) & 1) * 32 + (lane & 3) * 8;
    v16f negs;
#pragma unroll
    for (int i = 0; i < 16; ++i) negs[i] = -shift2;
    asm volatile("" : "+v"(negs));
    for (int su = c0; su < BATCH * 4 * 4; su += G) {
        const int bkh = su >> 2, b = bkh >> 2, kh = bkh & 3, n0 = (su & 3) * 4;
        const int head = kh * 4 + gh;
        if (n0 > 0) attn_dma_block(lds, Kg, Vg, bkh, n0 - 1, wid, lane);
        attn_dma_block(lds, Kg, Vg, bkh, n0, wid, lane);
        attn_dma_block(lds, Kg, Vg, bkh, n0 + 1, wid, lane);
        s8x qf[2][4];
#pragma unroll
        for (int qs = 0; qs < 2; ++qs)
#pragma unroll
            for (int ds = 0; ds < 4; ++ds) qf[qs][ds] = __builtin_nontemporal_load((const s8x*)(Q + ((size_t)((b * SEQ + n0 * 128 + qoff + 32 * qs) >> 5) * 16 + head) * 2048 + ((2 * ds + h) * 32 + r) * 8));
        asm volatile("s_waitcnt vmcnt(0)" ::: "memory");
        __syncthreads();
#pragma unroll 1
        for (int n = n0; n < n0 + 4; ++n) {
            const int kt0 = (n == 0) ? 2 : 0, kt1 = (n == 15) ? 4 : 6;
            const int row0 = b * SEQ + n * 128 + qoff;
            if (n < n0 + 3 && n + 2 <= 15) attn_dma_block(lds, Kg, Vg, bkh, n + 2, wid, lane);
            v16f o[2][2];
#pragma unroll
            for (int a = 0; a < 2; ++a)
#pragma unroll
                for (int c = 0; c < 2; ++c)
#pragma unroll
                    for (int i = 0; i < 16; ++i) o[a][c][i] = 0.f;
            float l0 = 0.f, l1 = 0.f;
            const int wlo = kt0 > par ? kt0 : par, whi = kt1 < 5 + par ? kt1 : 5 + par;
            v2u gwv[2][2][4];
#ifndef REP_ATTLOOP
#define REP_ATTLOOP 1
#endif
_Pragma("unroll 1")
            for (int rep_ = 0; rep_ < REP_ATTLOOP; ++rep_) {
            const int s0 = 2 * wlo, s1 = 2 * whi;
#define ATT_KADDR(stp) ((lds_cptr)lds + ((n - 1 + ((stp) >> 2)) & 3) * 16384 + (((stp) >> 1) & 1) * 8192 + h * 1024 + (32 * ((stp) & 1) + r) * 16)
#define ATT_VADDR(stp) ((lds_cptr)lds + 65536 + ((n - 1 + ((stp) >> 2)) & 3) * 16384 + (((stp) >> 1) & 1) * 8192 + ((stp) & 1) * 2048 + voff)
#define ATT_MASK(stp, A0, A1) do { const int kt_ = (stp) >> 1; if ((kt_ == par) || (kt_ == 4 + par)) { asm volatile("" ::: "memory"); \
                const int cb = 32 * (stp) + 4 * h, iq0 = qoff + r, iq1 = iq0 + 32; \
                _Pragma("unroll") for (int i = 0; i < 16; ++i) { const int c = cb + (i & 3) + 8 * (i >> 2); \
                    if (!(c >= iq0 && c <= iq0 + 256)) A0[i] = -INFINITY; if (!(c >= iq1 && c <= iq1 + 256)) A1[i] = -INFINITY; } } } while (0)
#define ATT_EXP_PACK(A0, A1, PK) do { _Pragma("unroll") for (int i = 0; i < 16; ++i) { A0[i] = __builtin_amdgcn_exp2f(A0[i]); A1[i] = __builtin_amdgcn_exp2f(A1[i]); l0 += A0[i]; l1 += A1[i]; } \
                _Pragma("unroll") for (int s = 0; s < 2; ++s) _Pragma("unroll") for (int j = 0; j < 4; ++j) { PK[s][0][j] = pk_bf16(A0[8 * s + 2 * j], A0[8 * s + 2 * j + 1]); PK[s][1][j] = pk_bf16(A1[8 * s + 2 * j], A1[8 * s + 2 * j + 1]); } } while (0)
            s8x kfr[4]; v4u pcur[2][2];
            {   const lds_cptr kp = ATT_KADDR(s0);
#pragma unroll
                for (int ds = 0; ds < 4; ++ds) kfr[ds] = *(const LAS s8x*)(kp + ds * 2048);
                v16f st0 = negs, st1 = negs;
#pragma unroll
                for (int ds = 0; ds < 4; ++ds) { st0 = MFMA32(kfr[ds], qf[0][ds], st0); st1 = MFMA32(kfr[ds], qf[1][ds], st1); }
                const lds_cptr kp2 = ATT_KADDR(s0 + 1 < s1 ? s0 + 1 : s0);
#pragma unroll
                for (int ds = 0; ds < 4; ++ds) kfr[ds] = *(const LAS s8x*)(kp2 + ds * 2048);
                ATT_MASK(s0, st0, st1);
                ATT_EXP_PACK(st0, st1, pcur);
            }
#pragma unroll 1
            for (int step = s0; step < s1 - 1; ++step) {
                s8x vf[2][2];
                {   const lds_cptr vp = ATT_VADDR(step);
#pragma unroll
                    for (int s = 0; s < 2; ++s)
#pragma unroll
                        for (int dblk = 0; dblk < 2; ++dblk) { const v4i16_t lo = vtr(vp + dblk * 4096 + s * 1024), hi = vtr(vp + dblk * 4096 + s * 1024 + 512); vf[s][dblk] = __builtin_shufflevector(lo, hi, 0, 1, 2, 3, 4, 5, 6, 7); } }
                v16f st0 = negs, st1 = negs;
#pragma unroll
                for (int ds = 0; ds < 4; ++ds) { st0 = MFMA32(kfr[ds], qf[0][ds], st0); st1 = MFMA32(kfr[ds], qf[1][ds], st1); }
                {   const lds_cptr kp = ATT_KADDR(step + 2 < s1 ? step + 2 : step + 1);
#pragma unroll
                    for (int ds = 0; ds < 4; ++ds) kfr[ds] = *(const LAS s8x*)(kp + ds * 2048); }
                ATT_MASK(step + 1, st0, st1);
                __builtin_amdgcn_sched_barrier(0);
                v4u pnext[2][2];
#pragma unroll
                for (int s = 0; s < 2; ++s)
#pragma unroll
                    for (int dblk = 0; dblk < 2; ++dblk) { o[dblk][0] = MFMA32(vf[s][dblk], __builtin_bit_cast(s8x, pcur[s][0]), o[dblk][0]); o[dblk][1] = MFMA32(vf[s][dblk], __builtin_bit_cast(s8x, pcur[s][1]), o[dblk][1]); }
                ATT_EXP_PACK(st0, st1, pnext);
#pragma unroll
                for (int k = 0; k < 8; ++k) { __builtin_amdgcn_sched_group_barrier(0x008, 1, 0); __builtin_amdgcn_sched_group_barrier(0x002, 11, 0); }
                __builtin_amdgcn_sched_barrier(0);
#pragma unroll
                for (int s = 0; s < 2; ++s) { pcur[s][0] = pnext[s][0]; pcur[s][1] = pnext[s][1]; }
            }
            if (n < n0 + 3) {
#pragma unroll
                for (int qs = 0; qs < 2; ++qs)
#pragma unroll
                    for (int ds = 0; ds < 4; ++ds) qf[qs][ds] = __builtin_nontemporal_load((const s8x*)(Q + ((size_t)((row0 + 128 + 32 * qs) >> 5) * 16 + head) * 2048 + ((2 * ds + h) * 32 + r) * 8));
            }
#pragma unroll
            for (int qs = 0; qs < 2; ++qs)
#pragma unroll
                for (int dblk = 0; dblk < 2; ++dblk)
#pragma unroll
                    for (int gi = 0; gi < 4; ++gi) gwv[qs][dblk][gi] = __builtin_nontemporal_load((const v2u*)(Gt + ((size_t)((row0 + 32 * qs) >> 5) * 16 + head) * 2048 + r * 8 + h * 4 + (dblk * 4 + gi) * 256));
            {
                const lds_cptr vp = ATT_VADDR(s1 - 1);
#pragma unroll
                for (int s = 0; s < 2; ++s)
#pragma unroll
                    for (int dblk = 0; dblk < 2; ++dblk) { const v4i16_t lo = vtr(vp + dblk * 4096 + s * 1024), hi = vtr(vp + dblk * 4096 + s * 1024 + 512); const s8x vfr = __builtin_shufflevector(lo, hi, 0, 1, 2, 3, 4, 5, 6, 7);
                        o[dblk][0] = MFMA32(vfr, __builtin_bit_cast(s8x, pcur[s][0]), o[dblk][0]); o[dblk][1] = MFMA32(vfr, __builtin_bit_cast(s8x, pcur[s][1]), o[dblk][1]); }
            }
            }
#undef ATT_KADDR
#undef ATT_VADDR
#undef ATT_MASK
#undef ATT_EXP_PACK
            asm volatile("s_waitcnt vmcnt(0)" ::: "memory");
            __syncthreads();
            l0 += __shfl_xor(l0, 32); l1 += __shfl_xor(l1, 32);
            const float sk = (float)REP_ATTLOOP * __builtin_amdgcn_exp2f(sink[head] * LOG2E - shift2);
            const float inv0 = 1.f / (l0 + sk), inv1 = 1.f / (l1 + sk);
#pragma unroll
            for (int qs = 0; qs < 2; ++qs) {
                bf16_t* op = OG + (size_t)(row0 + 32 * qs + r) * 1024 + head * 64 + h * 32;
                const float inv = qs ? inv1 : inv0;
#pragma unroll
                for (int dblk = 0; dblk < 2; ++dblk) {
                    unsigned w[8];
#pragma unroll
                    for (int gi = 0; gi < 4; ++gi) {
                        const float a0 = o[dblk][qs][4 * gi] * inv * silu_f(bf_lo(gwv[qs][dblk][gi].x)), a1 = o[dblk][qs][4 * gi + 1] * inv * silu_f(bf_hi(gwv[qs][dblk][gi].x));
                        const float a2 = o[dblk][qs][4 * gi + 2] * inv * silu_f(bf_lo(gwv[qs][dblk][gi].y)), a3 = o[dblk][qs][4 * gi + 3] * inv * silu_f(bf_hi(gwv[qs][dblk][gi].y));
                        w[2 * gi] = pk_bf16(a0, a1); w[2 * gi + 1] = pk_bf16(a2, a3);
                    }
                    *(v4u*)(op + dblk * 16) = (v4u){w[0], w[1], w[2], w[3]}; *(v4u*)(op + dblk * 16 + 8) = (v4u){w[4], w[5], w[6], w[7]};
                }
            }
        }
    }
}

__device__ __forceinline__ void unpack8(const v4u w, float (&f)[8]) { f[0] = bf_lo(w.x); f[1] = bf_hi(w.x); f[2] = bf_lo(w.y); f[3] = bf_hi(w.y); f[4] = bf_lo(w.z); f[5] = bf_hi(w.z); f[6] = bf_lo(w.w); f[7] = bf_hi(w.w); }
template <class Sched> __device__ __forceinline__ void conv_fix_tiles(const Sched& S, bf16_t* __restrict__ Y, const float* __restrict__ YP, const bf16_t* __restrict__ ZH, const bf16_t* __restrict__ CH) {
    int tid_ = threadIdx.x; asm volatile("" : "+v"(tid_));
    const int tid = tid_;
    pg8::Unit u;
    for (int i = 0; S.next(i, u); ++i) {
#pragma unroll
        for (int w = tid; w < 1024; w += 512) {
            const int rowi = w >> 7, g = 4 * u.pm + (rowi >> 1), side = rowi & 1, ch = (w & 127) * 8;
            const int t = 64 * g + (side ? 63 : 0);
            const bool has = side ? (((t + 1) & (SEQ - 1)) != 0) : ((t & (SEQ - 1)) != 0);
            const v4f y0 = *(const v4f*)(YP + (size_t)(2 * g + side) * 1024 + ch), y1 = *(const v4f*)(YP + (size_t)(2 * g + side) * 1024 + ch + 4);
            float y[8] = {y0[0], y0[1], y0[2], y0[3], y1[0], y1[1], y1[2], y1[3]};
            if (has) {
                const v4u cwv = *(const v4u*)(CH + (size_t)(2 * g + side) * 1024 + ch);
                const v4u zw = *(const v4u*)(ZH + (size_t)(side ? 2 * (g + 1) : 2 * (g - 1) + 1) * 1024 + ch);
                float c[8], z[8]; unpack8(cwv, c); unpack8(zw, z);
#pragma unroll
                for (int k = 0; k < 8; ++k) y[k] += c[k] * z[k];
            }
            v4u o; o.x = pk_bf16(y[0], y[1]); o.y = pk_bf16(y[2], y[3]); o.z = pk_bf16(y[4], y[5]); o.w = pk_bf16(y[6], y[7]);
            *(v4u*)(Y + (size_t)t * 1024 + ch) = o;
        }
    }
    asm volatile("s_waitcnt vmcnt(0)" ::: "memory");
    __syncthreads();
}

__device__ __forceinline__ int dst_row(int kind, int j) {
    if (kind == 0) return j;
    if (kind == 1) { const int pn = j >> 8, jj = j & 255, head = jj >> 6, d = jj & 63; return pn * 256 + (d >> 5) * 128 + head * 32 + (d & 31); }
    const int knd = j >> 10, chan = j & 1023, pn = chan >> 6, cl = chan & 63, wc = cl >> 4, fq = (cl >> 2) & 3, i = cl & 3;
    return pn * 256 + (knd >> 1) * 128 + wc * 32 + fq * 8 + (knd & 1) * 4 + i;
}
__device__ __forceinline__ int kperm_og(int kp) { const int p = kp & 63, hh = p >> 5, dblk = (p >> 4) & 1, i = p & 15; return (kp & ~63) | (32 * dblk + 8 * (i >> 2) + 4 * hh + (i & 3)); }
__device__ __forceinline__ void transpose_block(const float* __restrict__ W, int K, int N, bf16_t* __restrict__ WT, int kind, const float* __restrict__ g, LAS float* T, int item, int tid, bool kp) {
    const int nblk = N / 256, kb = item / nblk, nb = item % nblk, k0 = 64 * kb, n0 = 256 * nb;
    constexpr int P = 257;
#pragma unroll
    for (int i = 0; i < 8; ++i) {
        const int q = tid + 512 * i, kk = q >> 6, c4 = q & 63;
        const int ks = kp ? kperm_og(k0 + kk) : (k0 + kk);
        v4f w = __builtin_nontemporal_load((const v4f*)(W + (size_t)ks * N + n0 + 4 * c4));
        if (g) w = w * g[ks];
        LAS float* t = T + kk * P + 4 * c4;
        t[0] = w[0]; t[1] = w[1]; t[2] = w[2]; t[3] = w[3];
    }
    __syncthreads();
#pragma unroll
    for (int j = 0; j < 4; ++j) {
        const int o = tid + 512 * j, c = o & 7, n = o >> 3;
        const LAS float* t = T + (8 * c) * P + n;
        v4u ov; ov.x = pk_bf16(t[0], t[P]); ov.y = pk_bf16(t[2 * P], t[3 * P]); ov.z = pk_bf16(t[4 * P], t[5 * P]); ov.w = pk_bf16(t[6 * P], t[7 * P]);
        *(v4u*)(WT + (size_t)dst_row(kind, n0 + n) * K + k0 + 8 * c) = ov;
    }
    __syncthreads();
}

#define XB_TMO      128
#define XB_XCNT(j)  (256  + 64 * (j))
#define XB_XSUB(j)  (1280 + 64 * (j))
#define XB_XGEN(j)  (2304 + 64 * (j))
#define XB_TOP      3328
#define XB_TOPGEN   3392
#define XCD_BAR_WORDS 3456
#define XB_SPIN_CAP (1u << 18)

__device__ __forceinline__ unsigned xb_ld(unsigned* p)              { return __hip_atomic_load(p, __ATOMIC_RELAXED, __HIP_MEMORY_SCOPE_AGENT); }
__device__ __forceinline__ unsigned xb_add(unsigned* p, unsigned v) { return __hip_atomic_fetch_add(p, v, __ATOMIC_RELAXED, __HIP_MEMORY_SCOPE_AGENT); }
__device__ __forceinline__ unsigned xb_xcc_id() { return (unsigned)__builtin_amdgcn_s_getreg((3 << 11) | 20) & 0xFu; }
#define XB_SPIN(cond, bar) do { unsigned _sp = 0; while (cond) { __builtin_amdgcn_s_sleep(1); \
    if ((++_sp & 255u) == 0u) { if (xb_ld(&(bar)[XB_TMO])) break; if (_sp > XB_SPIN_CAP) { atomicAdd(&(bar)[XB_TMO], 1u); break; } } } } while (0)

struct XcdBarrier {
    unsigned* bar; unsigned x;
    volatile LAS unsigned* st;
};

__device__ __forceinline__ XcdBarrier xcd_barrier_post(unsigned* bar, volatile LAS unsigned* st) {
    XcdBarrier b; b.bar = bar; b.x = xb_xcc_id(); b.st = st;
    if (threadIdx.x == 0) (void)xb_add(&bar[XB_XCNT(b.x)], 1u);
    return b;
}
__device__ __forceinline__ void xcd_barrier_complete(unsigned* bar, unsigned x, unsigned& nloc, unsigned& nx) {
    const unsigned G = gridDim.x * gridDim.y * gridDim.z;
    unsigned sum, cnt, mine, sp = 0u;
    for (;;) {
        sum = 0u; cnt = 0u; mine = 0u;
#pragma unroll
        for (unsigned j = 0; j < 16; ++j) { const unsigned c = xb_ld(&bar[XB_XCNT(j)]); sum += c; cnt += (c > 0u) ? 1u : 0u; mine = (j == x) ? c : mine; }
        if (sum == G) break;
        __builtin_amdgcn_s_sleep(1);
        if ((++sp & 255u) == 0u) { if (xb_ld(&bar[XB_TMO])) break; if (sp > XB_SPIN_CAP) { atomicAdd(&bar[XB_TMO], 1u); break; } }
    }
    nloc = mine > 0u ? mine : 1u; nx = cnt > 0u ? cnt : 1u;
}

__device__ __forceinline__ void xcd_barrier(const XcdBarrier& b) {
    asm volatile("s_waitcnt vmcnt(0)" ::: "memory");
    __syncthreads();
    if (threadIdx.x == 0) {
        unsigned* bar = b.bar;
        __builtin_amdgcn_s_waitcnt(0);
        unsigned nloc = b.st[0], nx = b.st[1];
        if (nloc == 0u) { xcd_barrier_complete(bar, b.x, nloc, nx); b.st[0] = nloc; b.st[1] = nx; }
        const unsigned old = xb_add(&bar[XB_XSUB(b.x)], 1u);
        const unsigned gen = old / nloc;
        if (old + 1u == (gen + 1u) * nloc) {
            __builtin_amdgcn_fence(__ATOMIC_RELEASE, "agent");
            asm volatile("s_waitcnt vmcnt(0)" ::: "memory");
            const unsigned og = xb_add(&bar[XB_TOP], 1u);
            const unsigned tg = og / nx;
            if (og + 1u == (tg + 1u) * nx) xb_add(&bar[XB_TOPGEN], 1u);
            else XB_SPIN(xb_ld(&bar[XB_TOPGEN]) == tg, bar);
            __builtin_amdgcn_fence(__ATOMIC_ACQUIRE, "agent");
            xb_add(&bar[XB_XGEN(b.x)], 1u);
            asm volatile("s_waitcnt vmcnt(0)" ::: "memory");
        } else {
            XB_SPIN(xb_ld(&bar[XB_XGEN(b.x)]) == gen, bar);
            __builtin_amdgcn_fence(__ATOMIC_ACQUIRE, "agent");
            asm volatile("s_waitcnt vmcnt(0)" ::: "memory");
        }
    }
    __syncthreads();
}

constexpr size_t MiB = 1u << 20;
constexpr size_t WS_COS = 1 * MiB, WS_SIN = WS_COS + 256 * 1024;
constexpr size_t WS_SS = 2 * MiB;
constexpr size_t WS_WAIN = 4 * MiB, WS_WAOUT = 14 * MiB, WS_WBIN = 18 * MiB, WS_WBOUT = 34 * MiB;
constexpr size_t WS_XB = 40 * MiB;
constexpr size_t WS_Q = 104 * MiB;
constexpr size_t WS_G = 168 * MiB;
constexpr size_t WS_K = 232 * MiB, WS_V = 248 * MiB;
constexpr size_t WS_OG = 264 * MiB;
constexpr size_t WS_END = 328 * MiB;
constexpr int LDS_BYTES = 147456;

template <class Sched> __device__ __forceinline__ pg8::RstdTab rstd_table_fill(const Sched& S, LAS float* tab, const float* ss, LAS float* xdst, const float* xsrc0, int n0, const float* xsrc1, int n1) {
    int tid_ = threadIdx.x; asm volatile("" : "+v"(tid_));
    const int tid = tid_;
    for (int i = tid; i < n0; i += 512) xdst[i] = xsrc0[i];
    for (int i = tid; i < n1; i += 512) xdst[n0 + i] = xsrc1[i];
    pg8::Unit u; int pm0 = -1, pm1 = -1;
    for (int i = 0; S.next(i, u); ++i) { if (pm0 < 0) pm0 = u.pm; else if (u.pm != pm0 && pm1 < 0) pm1 = u.pm; }
    const int pm = (tid < 256) ? pm0 : pm1;
    if (pm >= 0) tab[tid] = pg8::row_rstd(ss, pm * 256 + (tid & 255));
    __syncthreads();
    return pg8::RstdTab{tab, pm0, pm1, ss};
}
#ifndef REP_P0
#define REP_P0 1
#endif
#ifndef REP_OUTX
#define REP_OUTX 0
#endif
#ifndef REP_AIN
#define REP_AIN 1
#endif
#ifndef REP_ATTN
#define REP_ATTN 1
#endif
#ifndef REP_AOUT0
#define REP_AOUT0 1
#endif
#ifndef REP_BIN
#define REP_BIN 1
#endif
#ifndef REP_CONV
#define REP_CONV 1
#endif
#ifndef GEMM_ALIGN
#define GEMM_ALIGN true
#endif
#ifndef GEMM_SP2
#define GEMM_SP2 true
#endif
struct Args { const float* in[10]; float* out; unsigned char* ws; int ph_lo, ph_hi; };
constexpr int N_PHASES = 13;

__global__ void __launch_bounds__(512, 2) fwd_kernel(Args args) {
    extern __shared__ __attribute__((aligned(16))) unsigned char lds_raw[];
    LAS unsigned char* lds = (LAS unsigned char*)lds_raw;
    cg::grid_group grid = cg::this_grid();
    const int tid = threadIdx.x, lane = tid & 63, wave = __builtin_amdgcn_readfirstlane(tid >> 6);
    const int G = gridDim.x, bx = blockIdx.x;
    unsigned char* ws = args.ws;
    const float* x_in = args.in[0]; const float* norm_g = args.in[1]; const float* a_w_in = args.in[2]; const float* a_qn = args.in[3]; const float* a_kn = args.in[4];
    const float* a_sink = args.in[5]; const float* a_w_out = args.in[6]; const float* b_w_in = args.in[7]; const float* b_conv = args.in[8]; const float* b_w_out = args.in[9];
    float* out = args.out;
    _Float16* csT = (_Float16*)(ws + WS_COS); float* ss = (float*)(ws + WS_SS);
    bf16_t* XB = (bf16_t*)(ws + WS_XB); bf16_t* QB = (bf16_t*)(ws + WS_Q); bf16_t* GB = (bf16_t*)(ws + WS_G); bf16_t* KB = (bf16_t*)(ws + WS_K); bf16_t* VB = (bf16_t*)(ws + WS_V); bf16_t* OGB = (bf16_t*)(ws + WS_OG);
    const int lo = args.ph_lo, hi = args.ph_hi;
#define IN(k) (lo <= (k) && (k) < hi)
#ifdef SEAM_X3
#define SEAM(k) do { if (IN(k) && IN((k) + 1)) { xcd_barrier(bar); xcd_barrier(bar); xcd_barrier(bar); } } while (0)
#else
#define SEAM(k) do { if (IN(k) && IN((k) + 1)) xcd_barrier(bar); } while (0)
#endif
    if (args.ph_lo < 0) grid.sync();
    if (tid < 16) ((LAS unsigned*)(lds + 131072))[tid] = 0u;
    __syncthreads();
    XcdBarrier bar = xcd_barrier_post((unsigned*)ws, (volatile LAS unsigned*)(lds + 131072) + 8);

#ifndef NO_P0
    if (IN(0))
_Pragma("unroll 1")
    for (int rep = 0; rep < REP_P0; ++rep) {
        const int gw = bx * 8 + wave, NGW = G * 8;
        {
            LAS float* T = (LAS float*)lds;
            constexpr int I_AIN = 16 * (A_IN / 256), I_OUT = 16 * 4, I_BIN = 16 * (B_IN / 256);
            constexpr int PER_PAIR = I_AIN + I_OUT + I_BIN + I_OUT;
            int tid_ = threadIdx.x; asm volatile("" : "+v"(tid_));
            for (int it = bx; it < 2 * PER_PAIR; it += G) {
                const int sl = it / PER_PAIR; int rr = it % PER_PAIR;
                if (rr < I_AIN) { transpose_block(a_w_in + (size_t)sl * DM * A_IN, DM, A_IN, (bf16_t*)(ws + WS_WAIN) + (size_t)sl * DM * A_IN, 1, norm_g + (2 * sl) * DM, T, rr, tid_, false); continue; } rr -= I_AIN;
                if (rr < I_OUT) { transpose_block(a_w_out + (size_t)sl * DM * DM, DM, DM, (bf16_t*)(ws + WS_WAOUT) + (size_t)sl * DM * DM, 0, nullptr, T, rr, tid_, true); continue; } rr -= I_OUT;
                if (rr < I_BIN) { transpose_block(b_w_in + (size_t)sl * DM * B_IN, DM, B_IN, (bf16_t*)(ws + WS_WBIN) + (size_t)sl * DM * B_IN, 2, norm_g + (2 * sl + 1) * DM, T, rr, tid_, false); continue; } rr -= I_BIN;
                transpose_block(b_w_out + (size_t)sl * DM * DM, DM, DM, (bf16_t*)(ws + WS_WBOUT) + (size_t)sl * DM * DM, 0, nullptr, T, rr, tid_, false);
            }
        }
        for (int idx = bx * 512 + tid; idx < SEQ * 32; idx += G * 512) {
            const int t = idx >> 5, f = idx & 31;
            const float inv_freq = __builtin_amdgcn_exp2f(-(float)f * (13.287712379549449f / 32.f));
            const float ang = (float)t * inv_freq;
            double rv = (double)ang * 0.15915494309189535; rv -= __builtin_rint(rv);
            const float fr = (float)rv;
            _Float16* cp = csT + ((size_t)t * 4 + (f >> 3)) * 16 + (f & 7);
            cp[0] = (_Float16)__builtin_amdgcn_cosf(fr); cp[8] = (_Float16)__builtin_amdgcn_sinf(fr);
        }
        for (int m0 = gw; m0 < MTOK; m0 += 4 * NGW) {
            v4f v[4][4]; float s[4];
#pragma unroll
            for (int q = 0; q < 4; ++q) { const int m = m0 + q * NGW; if (m < MTOK) { const v4f* xr = (const v4f*)(x_in + (size_t)m * DM) + lane;
#pragma unroll
                for (int j = 0; j < 4; ++j) v[q][j] = __builtin_nontemporal_load(xr + 64 * j); } }
#pragma unroll
            for (int q = 0; q < 4; ++q) { const int m = m0 + q * NGW; if (m < MTOK) {
                s[q] = 0.f;
#pragma unroll
                for (int j = 0; j < 4; ++j) s[q] += (v[q][j][0] * v[q][j][0] + v[q][j][1] * v[q][j][1]) + (v[q][j][2] * v[q][j][2] + v[q][j][3] * v[q][j][3]);
#pragma unroll
                for (int o = 1; o < 64; o <<= 1) s[q] += __shfl_xor(s[q], o);
                v2u* o8 = (v2u*)(XB + (size_t)m * DM) + lane;
#pragma unroll
                for (int j = 0; j < 4; ++j) { v2u w; w.x = pk_bf16(v[q][j][0], v[q][j][1]); w.y = pk_bf16(v[q][j][2], v[q][j][3]); o8[64 * j] = w; }
                if (lane < 16) ss[(size_t)m * 16 + lane] = (lane == 0) ? s[q] : 0.f; } }
        }
    }
#endif
    SEAM(0);

#pragma unroll 1
    for (int L = 0; L < 4; ++L) {
        const int sl = L >> 1, p0 = 1 + 3 * L;
        if ((L & 1) == 0) {
            if (IN(p0)) {
                pg8::Gemm g{XB, (const bf16_t*)(ws + WS_WAIN) + (size_t)sl * DM * A_IN, MTOK, A_IN, DM};
                pg8::StaticOrder S; S.init(MTOK, A_IN, G, bx);
                LAS float* gl = (LAS float*)(lds + 131072 + 256 + 2048);
                const pg8::RstdTab rt = rstd_table_fill(S, (LAS float*)(lds + 131072 + 256), ss, gl, a_qn + sl * 64, 64, a_kn + sl * 64, 64);
                pg8::EpiAin E{QB, KB, VB, GB, rt, gl, gl + 64, csT};
#ifndef NO_AIN
_Pragma("unroll 1")
                for (int rep = 0; rep < REP_AIN; ++rep) pg8::gemm_phase<pg8::EpiAin, pg8::StaticOrder, GEMM_ALIGN, GEMM_SP2>(lds, g, S, E);
#endif
            }
            SEAM(p0);
            if (IN(p0 + 1)) {
                float mq = fabsf(a_qn[sl * 64 + lane]), mk = fabsf(a_kn[sl * 64 + lane]);
#pragma unroll
                for (int o = 1; o < 64; o <<= 1) { mq = fmaxf(mq, __shfl_xor(mq, o)); mk = fmaxf(mk, __shfl_xor(mk, o)); }
                const float shift2 = 11.7f * mq * mk;
#ifndef NO_ATTN
_Pragma("unroll 1")
                for (int rep = 0; rep < REP_ATTN; ++rep) attn_phase(lds, QB, KB, VB, GB, OGB, a_sink + sl * 16, shift2, bx, G);
#endif
            }
            SEAM(p0 + 1);
            if (IN(p0 + 2)) {
                pg8::Gemm g{OGB, (const bf16_t*)(ws + WS_WAOUT) + (size_t)sl * DM * DM, MTOK, DM, DM};
                pg8::StaticOrder S; S.init(MTOK, DM, G, bx);
                pg8::EpiOut E{XB, ss, (L == 3) ? out : nullptr};
                if (REP_OUTX) { pg8::EpiOut E2{QB, (float*)(ws + WS_K), nullptr};
_Pragma("unroll 1")
                    for (int rep = 0; rep < REP_OUTX; ++rep) pg8::gemm_phase<pg8::EpiOut, pg8::StaticOrder, GEMM_ALIGN, GEMM_SP2>(lds, g, S, E2); }
#ifndef NO_OUT
_Pragma("unroll 1")
                for (int rep = 0; rep < ((L == 0) ? REP_AOUT0 : 1); ++rep) pg8::gemm_phase<pg8::EpiOut, pg8::StaticOrder, GEMM_ALIGN, GEMM_SP2, OUT_A_AUX>(lds, g, S, E);
#endif
            }
            SEAM(p0 + 2);
        } else {
            if (IN(p0)) {
                pg8::Gemm g{XB, (const bf16_t*)(ws + WS_WBIN) + (size_t)sl * DM * B_IN, MTOK, B_IN, DM};
                pg8::StaticOrder S; S.init(MTOK, B_IN, G, bx);
                LAS float* cwl = (LAS float*)(lds + 131072 + 256 + 2048);
                const pg8::RstdTab rt = rstd_table_fill(S, (LAS float*)(lds + 131072 + 256), ss, cwl, b_conv + sl * 3 * DM, 3 * DM, nullptr, 0);
                pg8::EpiBin E{OGB, KB, KB + (size_t)1024 * 1024, rt, cwl, (float*)(ws + WS_V)};
#ifndef NO_BIN
_Pragma("unroll 1")
                for (int rep = 0; rep < REP_BIN; ++rep) pg8::gemm_phase<pg8::EpiBin, pg8::StaticOrder, GEMM_ALIGN, GEMM_SP2>(lds, g, S, E);
#endif
            }
            SEAM(p0);
            if (IN(p0 + 2)) {
                pg8::Gemm g{OGB, (const bf16_t*)(ws + WS_WBOUT) + (size_t)sl * DM * DM, MTOK, DM, DM};
                pg8::StaticOrder S; S.init(MTOK, DM, G, bx);
                conv_fix_tiles(S, OGB, (const float*)(ws + WS_V), KB, KB + (size_t)1024 * 1024);
                pg8::EpiOut E{XB, ss, (L == 3) ? out : nullptr};
                if (REP_OUTX) { pg8::EpiOut E2{QB, (float*)(ws + WS_K), nullptr};
_Pragma("unroll 1")
                    for (int rep = 0; rep < REP_OUTX; ++rep) pg8::gemm_phase<pg8::EpiOut, pg8::StaticOrder, GEMM_ALIGN, GEMM_SP2>(lds, g, S, E2); }
#ifndef NO_OUT
                pg8::gemm_phase<pg8::EpiOut, pg8::StaticOrder, GEMM_ALIGN, GEMM_SP2, OUT_A_AUX>(lds, g, S, E);
#endif
            }
            if (L < 3) SEAM(p0 + 2);
        }
    }
#undef IN
#undef SEAM
}

#ifndef MK_SPLIT
#define MK_SPLIT 0
#endif
extern "C" void kernel_launch(void* const* d_in, const int* in_sizes, int n_in, void* d_out, int out_size, void* d_ws, size_t ws_size, hipStream_t stream) {
    static int grid = 0;
    if (grid == 0) {
        if (n_in != 10 || out_size != MTOK * DM || ws_size < WS_END) { fprintf(stderr, "kernel_launch: unexpected shapes (n_in %d out %d ws %zu)\n", n_in, out_size, ws_size); grid = -1; return; }
        int dev = 0, cus = 0, per_cu = 0;
        hipGetDevice(&dev); hipDeviceGetAttribute(&cus, hipDeviceAttributeMultiprocessorCount, dev);
        hipFuncSetAttribute((const void*)fwd_kernel, hipFuncAttributeMaxDynamicSharedMemorySize, LDS_BYTES);
        if (hipOccupancyMaxActiveBlocksPerMultiprocessor(&per_cu, (const void*)fwd_kernel, 512, LDS_BYTES) != hipSuccess || per_cu < 1) { fprintf(stderr, "kernel_launch: occupancy query says %d\n", per_cu); per_cu = 1; }
        (void)hipGetLastError();
        grid = cus * per_cu;
    }
    if (grid < 0) return;
    if (hipMemsetAsync(d_ws, 0, 16384, stream) != hipSuccess) { fprintf(stderr, "kernel_launch: memset failed\n"); return; }
    Args a{};
    for (int i = 0; i < 10; ++i) a.in[i] = (const float*)d_in[i];
    a.out = (float*)d_out; a.ws = (unsigned char*)d_ws;
#if MK_SPLIT
    for (int p = 0; p < N_PHASES; ++p) { a.ph_lo = p; a.ph_hi = p + 1; hipLaunchKernelGGL(fwd_kernel, dim3(grid), dim3(512), LDS_BYTES, stream, a); }
#else
    a.ph_lo = 0; a.ph_hi = N_PHASES;
    void* kargs[] = {&a};
    hipError_t e = hipLaunchCooperativeKernel((const void*)fwd_kernel, dim3(grid), dim3(512), kargs, LDS_BYTES, stream);
    if (e != hipSuccess) fprintf(stderr, "cooperative launch failed: %s (grid %d)\n", hipGetErrorString(e), grid);
#endif
}
```

```cpp
#include <hip/hip_runtime.h>
#include <hip/hip_cooperative_groups.h>
#include <cstdio>
#include <cstdint>
namespace cg = cooperative_groups;
namespace pg8 {
#define PG8_LAS __attribute__((address_space(3)))
typedef unsigned short bf16_t;
typedef short bf16x8 __attribute__((ext_vector_type(8)));
typedef float f32x4 __attribute__((ext_vector_type(4)));
typedef unsigned u32x4 __attribute__((ext_vector_type(4)));
constexpr int BM = 256, BK = 64, HALF = 128, HTB = HALF * BK * 2  , STAGE_BYTES = 8 * HTB, NXCD = 8, WGM = 8;

__host__ __device__ __forceinline__ int lds_byte(int r, int c) { const int st = (r >> 4) * 2 + (c >> 5), rr = r & 15, cc = c & 31, ob = rr * 64 + cc * 2; return st * 1024 + (ob ^ (((ob >> 9) & 1) << 5)); }
__host__ __device__ __forceinline__ void stage_rc(int b, int& R, int& C) { const int st = b / 1024, sb = b % 1024, swz = sb ^ (((sb >> 9) & 1) << 5); R = (st >> 1) * 16 + swz / 64; C = (st & 1) * 32 + (swz % 64) / 2; }
__host__ __device__ __forceinline__ int perm32(int rho) { const int n = rho >> 4, i = rho & 15; return 8 * (i >> 2) + 4 * n + (i & 3); }

struct Unit { int pm, pn; };
struct Gemm { const bf16_t* A; const bf16_t* Bt; int M, N, K; };

struct StaticOrder {
    int nM, nN, nwg, G, c;
    __host__ __device__ void init(int M, int N, int G_, int c_) { nM = M / BM; nN = N / BM; nwg = nM * nN; G = G_; c = c_; }
    __host__ __device__ bool next(int i, Unit& u) const {
        const long L = (long)i * G + c; if (L >= nwg) return false;
        int wgid = (int)L; { const int q = nwg / NXCD, r = nwg % NXCD, xcd = wgid % NXCD, off = wgid / NXCD; wgid = (xcd < r ? xcd * (q + 1) : r * (q + 1) + (xcd - r) * q) + off; }
        const int nig = WGM * nN, gid = wgid / nig, fm = gid * WGM, gsz = (nM - fm) < WGM ? (nM - fm) : WGM;
        u.pm = fm + ((wgid % nig) % gsz); u.pn = (wgid % nig) / gsz; return true;
    }
    __device__ __forceinline__ void a_ready(const Unit&) const {}
    __device__ __forceinline__ void done(const Unit&) const {}
};
__device__ __forceinline__ unsigned cvt_pk_bf16(float lo, float hi) { unsigned r; asm volatile("v_cvt_pk_bf16_f32 %0, %1, %2" : "=v"(r) : "v"(lo), "v"(hi)); return r; }
typedef float f32x2 __attribute__((ext_vector_type(2)));
template <class Epi, class Sched, bool ALIGN_EPI = false, bool SP2 = false, int A_AUX = 0>
__device__ __forceinline__ void gemm_phase(PG8_LAS unsigned char* lds, const Gemm g, const Sched& S, const Epi& E) {
    int tid_ = threadIdx.x; asm volatile("" : "+v"(tid_));
    const int tid = tid_, wid = __builtin_amdgcn_readfirstlane(tid >> 6), lane = tid & 63, wr = wid >> 2, wc = wid & 3, fr = lane & 15, fq = lane >> 4;
    const int K = g.K, nt = K / BK;
    unsigned voffA[2], voffB[2];
#pragma unroll
    for (int i = 0; i < 2; ++i) { int R, C; stage_rc(tid * 16 + i * 8192, R, C); const int Rb = Epi::PERM ? ((R & ~31) + perm32(R & 31)) : R;
        voffA[i] = (unsigned)(R * K + C) * 2u; voffB[i] = (unsigned)(Rb * K + C) * 2u; }
    const size_t kstep = (size_t)(BK * 2);
    const size_t hstep = (size_t)HALF * K * 2;
    const size_t tstep = 2 * hstep;
    const unsigned ldsw = (unsigned)wid * 1024u;
    const int aoff = lds_byte(wr * 64 + fr, fq * 8), boff = lds_byte(wc * 32 + fr, fq * 8);
#define PG8_SA(b, h) (((b) * 2 + (h)) * HTB)
#define PG8_SB(b, h) ((4 + (b) * 2 + (h)) * HTB)
#define PG8_STAGE(bufoff, gbase, voff) do { _Pragma("unroll") for (int _i = 0; _i < 2; ++_i) \
        __builtin_amdgcn_global_load_lds((const unsigned*)((const char*)(gbase) + (voff)[_i]), (PG8_LAS unsigned*)(lds + (bufoff) + ldsw + _i * 8192), 16, 0, 0); } while (0)
#define PG8_STAGE_A(bufoff, gbase, voff) do { _Pragma("unroll") for (int _i = 0; _i < 2; ++_i) \
        __builtin_amdgcn_global_load_lds((const unsigned*)((const char*)(gbase) + (voff)[_i]), (PG8_LAS unsigned*)(lds + (bufoff) + ldsw + _i * 8192), 16, 0, A_AUX); } while (0)
#define PG8_LDA(dst, b, h) do { _Pragma("unroll") for (int m = 0; m < 4; ++m) _Pragma("unroll") for (int k = 0; k < 2; ++k) dst[m][k] = *(const PG8_LAS bf16x8*)(lds + PG8_SA(b, h) + aoff + m * 2048 + k * 1024); } while (0)
#define PG8_LDB(dst, b, h) do { _Pragma("unroll") for (int n = 0; n < 2; ++n) _Pragma("unroll") for (int k = 0; k < 2; ++k) dst[n][k] = *(const PG8_LAS bf16x8*)(lds + PG8_SB(b, h) + boff + n * 2048 + k * 1024); } while (0)
#define PG8_MMA(ai, bj, At, Bt) do { __builtin_amdgcn_s_setprio(1); _Pragma("unroll") for (int m = 0; m < 4; ++m) _Pragma("unroll") for (int n = 0; n < 2; ++n) _Pragma("unroll") for (int k = 0; k < 2; ++k) \
        acc[ai][bj][m][n] = __builtin_amdgcn_mfma_f32_16x16x32_bf16(Bt[n][k], At[m][k], acc[ai][bj][m][n], 0, 0, 0); __builtin_amdgcn_s_setprio(0); } while (0)
#define PG8_WAIT_V(n) asm volatile("s_waitcnt vmcnt(" #n ")" ::: "memory")
#define PG8_WAIT_L(n) asm volatile("s_waitcnt lgkmcnt(" #n ")" ::: "memory")
#define PG8_BAR __builtin_amdgcn_s_barrier()
#define PG8_SCHED __builtin_amdgcn_sched_barrier(0)
    Unit cur, nxt; int ui = 0;
    if (!S.next(0, cur)) return;
    f32x4 acc[2][2][4][2];
#pragma unroll
    for (int a = 0; a < 2; ++a)
#pragma unroll
        for (int b = 0; b < 2; ++b)
#pragma unroll
            for (int m = 0; m < 4; ++m)
#pragma unroll
                for (int n = 0; n < 2; ++n) acc[a][b][m][n] = (f32x4){0.f, 0.f, 0.f, 0.f};
    bf16x8 At[4][2], B0[2][2], B1[2][2];
    const char* cA = (const char*)g.A + (size_t)cur.pm * tstep; const char* cB = (const char*)g.Bt + (size_t)cur.pn * tstep;
    S.a_ready(cur);
    if constexpr (SP2) {
        PG8_STAGE(PG8_SB(0, 0), cB, voffB); PG8_STAGE(PG8_SB(0, 1), cB + hstep, voffB); PG8_STAGE_A(PG8_SA(0, 0), cA, voffA); PG8_STAGE_A(PG8_SA(0, 1), cA + hstep, voffA);
        if (wr == 1) PG8_BAR;
        PG8_WAIT_V(2); PG8_BAR;
        PG8_STAGE(PG8_SB(1, 0), cB + kstep, voffB); PG8_STAGE_A(PG8_SA(1, 0), cA + kstep, voffA); PG8_STAGE(PG8_SB(1, 1), cB + hstep + kstep, voffB);
        PG8_WAIT_V(6); PG8_BAR;
    } else {
        PG8_STAGE(PG8_SB(0, 0), cB, voffB); PG8_STAGE_A(PG8_SA(0, 0), cA, voffA); PG8_STAGE(PG8_SB(0, 1), cB + hstep, voffB); PG8_STAGE_A(PG8_SA(0, 1), cA + hstep, voffA);
        if (wr == 1) PG8_BAR;
        PG8_WAIT_V(4); PG8_BAR;
        PG8_STAGE(PG8_SB(1, 0), cB + kstep, voffB); PG8_STAGE_A(PG8_SA(1, 0), cA + kstep, voffA); PG8_STAGE(PG8_SB(1, 1), cB + hstep + kstep, voffB);
        PG8_WAIT_V(6); PG8_BAR;
    }
    for (;;) {
        const bool has_next = S.next(ui + 1, nxt);
        const char* nA = has_next ? (const char*)g.A + (size_t)nxt.pm * tstep : cA; const char* nB = has_next ? (const char*)g.Bt + (size_t)nxt.pn * tstep : cB;
        for (int t = 0; t < nt; t += 2) {
            const bool last = (t == nt - 2);
            const char* a1 = cA + (size_t)(t + 1) * kstep;
            const char* a2 = last ? nA : cA + (size_t)(t + 2) * kstep; const char* b2 = last ? nB : cB + (size_t)(t + 2) * kstep;
            const char* a3 = a2 + kstep; const char* b3 = b2 + kstep;
            if (last && has_next) S.a_ready(nxt);
            if constexpr (SP2) {
            PG8_LDB(B0, 0, 0); PG8_LDB(B1, 0, 1); PG8_SCHED; PG8_LDA(At, 0, 0); PG8_STAGE_A(PG8_SA(1, 1), a1 + hstep, voffA);
            PG8_WAIT_V(8); PG8_WAIT_L(0); PG8_BAR; PG8_MMA(0, 0, At, B0); PG8_MMA(0, 1, At, B1); PG8_BAR; PG8_SCHED;
            PG8_LDA(At, 0, 1); PG8_STAGE(PG8_SB(0, 0), b2, voffB); PG8_STAGE(PG8_SB(0, 1), b2 + hstep, voffB); PG8_STAGE_A(PG8_SA(0, 0), a2, voffA);
            PG8_WAIT_V(8); PG8_WAIT_L(0); PG8_BAR; PG8_MMA(1, 0, At, B0); PG8_MMA(1, 1, At, B1); PG8_BAR; PG8_SCHED;
            PG8_LDB(B0, 1, 0); PG8_LDB(B1, 1, 1); PG8_SCHED; PG8_LDA(At, 1, 0); PG8_STAGE_A(PG8_SA(0, 1), a2 + hstep, voffA);
            PG8_WAIT_V(8); PG8_WAIT_L(0); PG8_BAR; PG8_MMA(0, 0, At, B0); PG8_MMA(0, 1, At, B1); PG8_BAR; PG8_SCHED;
            PG8_LDA(At, 1, 1); PG8_STAGE(PG8_SB(1, 0), b3, voffB); PG8_STAGE(PG8_SB(1, 1), b3 + hstep, voffB); PG8_STAGE_A(PG8_SA(1, 0), a3, voffA);
            PG8_WAIT_V(8); PG8_WAIT_L(0); PG8_BAR; PG8_MMA(1, 0, At, B0); PG8_MMA(1, 1, At, B1); PG8_BAR; PG8_SCHED;
            } else {
            PG8_LDB(B0, 0, 0); PG8_SCHED; PG8_LDA(At, 0, 0); PG8_STAGE_A(PG8_SA(1, 1), a1 + hstep, voffA);
            PG8_WAIT_L(8); PG8_BAR; PG8_WAIT_L(0); PG8_MMA(0, 0, At, B0); PG8_BAR; PG8_SCHED;
            PG8_LDB(B1, 0, 1); PG8_STAGE(PG8_SB(0, 0), b2, voffB);
            PG8_BAR; PG8_WAIT_L(0); PG8_MMA(0, 1, At, B1); PG8_BAR;
            PG8_LDA(At, 0, 1); PG8_STAGE_A(PG8_SA(0, 0), a2, voffA);
            PG8_BAR; PG8_WAIT_L(0); PG8_MMA(1, 0, At, B0); PG8_BAR; PG8_SCHED;
            PG8_STAGE(PG8_SB(0, 1), b2 + hstep, voffB);
            PG8_WAIT_V(6); PG8_BAR; PG8_MMA(1, 1, At, B1); PG8_BAR;
            PG8_LDB(B0, 1, 0); PG8_SCHED; PG8_LDA(At, 1, 0); PG8_STAGE_A(PG8_SA(0, 1), a2 + hstep, voffA);
            PG8_WAIT_L(8); PG8_BAR; PG8_WAIT_L(0); PG8_MMA(0, 0, At, B0); PG8_BAR; PG8_SCHED;
            PG8_LDB(B1, 1, 1); PG8_STAGE(PG8_SB(1, 0), b3, voffB);
            PG8_BAR; PG8_WAIT_L(0); PG8_MMA(0, 1, At, B1); PG8_BAR;
            PG8_LDA(At, 1, 1); PG8_STAGE_A(PG8_SA(1, 0), a3, voffA);
            PG8_BAR; PG8_WAIT_L(0); PG8_MMA(1, 0, At, B0); PG8_BAR; PG8_SCHED;
            PG8_STAGE(PG8_SB(1, 1), b3 + hstep, voffB);
            PG8_WAIT_V(6); PG8_BAR; PG8_MMA(1, 1, At, B1); PG8_BAR;
            }
        }
        if constexpr (ALIGN_EPI) { if (wr == 0) PG8_BAR; }
        if constexpr (!Epi::AFTER_DRAIN) { E(acc, cur, wr, wc, fr, fq); S.done(cur); }
        if (!has_next) break;
#pragma unroll
        for (int a = 0; a < 2; ++a)
#pragma unroll
            for (int b = 0; b < 2; ++b)
#pragma unroll
                for (int m = 0; m < 4; ++m)
#pragma unroll
                    for (int n = 0; n < 2; ++n) acc[a][b][m][n] = (f32x4){0.f, 0.f, 0.f, 0.f};
        cur = nxt; cA = nA; cB = nB; ++ui;
        if constexpr (ALIGN_EPI) { if (wr == 1) PG8_BAR; }
    }
    PG8_WAIT_V(0);
    if constexpr (!ALIGN_EPI) { if (wr == 0) PG8_BAR; }
    PG8_BAR;
    if constexpr (Epi::AFTER_DRAIN) { E.fused(acc, cur, wr, wc, fr, fq, lds, wid, lane); S.done(cur); }
#undef PG8_SA
#undef PG8_SB
#undef PG8_STAGE
#undef PG8_STAGE_A
#undef PG8_LDA
#undef PG8_LDB
#undef PG8_MMA
#undef PG8_WAIT_V
#undef PG8_WAIT_L
#undef PG8_BAR
#undef PG8_SCHED
}
}

#ifndef OUT_A_AUX
#define OUT_A_AUX 0
#endif
#ifndef KV_AUX
#define KV_AUX 2
#endif
constexpr int BATCH = 16, SEQ = 2048, DM = 1024, MTOK = BATCH * SEQ;
constexpr int A_IN = 2560, B_IN = 4096;
constexpr float LOG2E = 1.4426950408889634f;
constexpr float QSCALE = 0.125f * LOG2E;
constexpr float NORM_EPS = 1e-6f;

#define LAS __attribute__((address_space(3)))
typedef float v4f __attribute__((ext_vector_type(4)));
typedef unsigned v4u __attribute__((ext_vector_type(4)));
typedef unsigned v2u __attribute__((ext_vector_type(2)));
typedef short s8x __attribute__((ext_vector_type(8)));
typedef float v16f __attribute__((ext_vector_type(16)));
typedef unsigned short bf16_t;

__device__ __forceinline__ float bf_lo(unsigned w) { return __uint_as_float(w << 16); }
__device__ __forceinline__ float bf_hi(unsigned w) { return __uint_as_float(w & 0xffff0000u); }
__device__ __forceinline__ float silu_f(float x) { return x * __builtin_amdgcn_rcpf(1.f + __builtin_amdgcn_exp2f(-x * LOG2E)); }
__device__ __forceinline__ unsigned pk_bf16(float lo, float hi) { return pg8::cvt_pk_bf16(lo, hi); }

namespace pg8 {
typedef unsigned u32x2 __attribute__((ext_vector_type(2)));
__device__ __forceinline__ float row_rstd(const float* ss, int row) {
    const f32x4* p = (const f32x4*)(ss + (size_t)row * 16);
    const f32x4 a = p[0], b = p[1], c = p[2], d = p[3];
    const float s = (((a[0] + a[1]) + (a[2] + a[3])) + ((b[0] + b[1]) + (b[2] + b[3]))) + (((c[0] + c[1]) + (c[2] + c[3])) + ((d[0] + d[1]) + (d[2] + d[3])));
    return __builtin_amdgcn_rsqf(s * (1.f / 1024.f) + NORM_EPS);
}
struct RstdTab { const PG8_LAS float* tab; int pm0, pm1; const float* ss;
    __device__ __forceinline__ float get(int pm, int rl) const { return (pm == pm0) ? tab[rl] : (pm == pm1) ? tab[256 + rl] : row_rstd(ss, pm * 256 + rl); } };
struct EpiAin {
    static constexpr bool PERM = true, AFTER_DRAIN = false;
    bf16_t *Q, *Kb, *Vb, *Gt; RstdTab rt; const float *gq, *gk, *cosT, *sinT;
    __device__ __forceinline__ void operator()(const f32x4 (&acc)[2][2][4][2], const Unit& u, int wr, int wc, int fr, int fq) const {
        const int pn = u.pn;
        if (pn <= 4) {
            const bool isq = pn < 4;
            const float* gp = isq ? gq : gk;
            const float osc = isq ? QSCALE : 1.f;
            f32x4 gv[2][2];
#pragma unroll
            for (int bj = 0; bj < 2; ++bj)
#pragma unroll
                for (int n = 0; n < 2; ++n) gv[bj][n] = *(const f32x4*)(gp + 32 * bj + 8 * fq + 4 * n);
#pragma unroll
            for (int ai = 0; ai < 2; ++ai)
#pragma unroll
                for (int m = 0; m < 4; ++m) {
                    const int row = u.pm * BM + ai * HALF + wr * 64 + m * 16 + fr;
                    const float rstd = rt.get(u.pm, ai * HALF + wr * 64 + m * 16 + fr);
                    f32x4 v[2][2]; float sq = 0.f;
#pragma unroll
                    for (int bj = 0; bj < 2; ++bj)
#pragma unroll
                        for (int n = 0; n < 2; ++n) { v[bj][n] = acc[ai][bj][m][n] * rstd; const f32x4 t2 = v[bj][n] * v[bj][n]; sq += (t2[0] + t2[1]) + (t2[2] + t2[3]); }
                    sq += __shfl_xor(sq, 16); sq += __shfl_xor(sq, 32);
                    const float rn = __builtin_amdgcn_rsqf(sq * (1.f / 64.f) + NORM_EPS);
                    const int t = row & (SEQ - 1);
                    u32x4 w0, w1;
#pragma unroll
                    for (int n = 0; n < 2; ++n) {
                        const f32x4 cs = *(const f32x4*)(cosT + t * 32 + 8 * fq + 4 * n), sn = *(const f32x4*)(sinT + t * 32 + 8 * fq + 4 * n);
                        const f32x4 y1 = v[0][n] * rn * gv[0][n], y2 = v[1][n] * rn * gv[1][n];
                        const f32x4 o1 = (y1 * cs - y2 * sn) * osc, o2 = (y2 * cs + y1 * sn) * osc;
                        w0[2 * n] = cvt_pk_bf16(o1[0], o1[1]); w0[2 * n + 1] = cvt_pk_bf16(o1[2], o1[3]);
                        w1[2 * n] = cvt_pk_bf16(o2[0], o2[1]); w1[2 * n + 1] = cvt_pk_bf16(o2[2], o2[3]);
                    }
                    if (isq) { bf16_t* p = Q + ((size_t)(row >> 5) * 16 + (4 * pn + wc)) * 2048 + (row & 31) * 8;
                        *(u32x4*)(p + fq * 256) = w0; *(u32x4*)(p + (4 + fq) * 256) = w1; }
                    else {
                        const int b = row >> 11; bf16_t* p = Kb + (size_t)((b * 4 + wc) * 32 + (t >> 6)) * 4096 + (t & 63) * 8;
                        *(u32x4*)(p + fq * 512) = w0; *(u32x4*)(p + (4 + fq) * 512) = w1;
                    }
                }
        } else if (pn == 5) {
#pragma unroll
            for (int ai = 0; ai < 2; ++ai)
#pragma unroll
                for (int m = 0; m < 4; ++m) {
                    const int row = u.pm * BM + ai * HALF + wr * 64 + m * 16 + fr;
                    const float rstd = rt.get(u.pm, ai * HALF + wr * 64 + m * 16 + fr);
                    const int t = row & (SEQ - 1), b = row >> 11;
                    bf16_t* p = Vb + (size_t)((b * 4 + wc) * 32 + (t >> 6)) * 4096 + ((t & 63) >> 3) * 256 + (t & 7) * 32 + 8 * fq;
#pragma unroll
                    for (int bj = 0; bj < 2; ++bj) { const f32x4 a = acc[ai][bj][m][0] * rstd, c = acc[ai][bj][m][1] * rstd;
                        u32x4 w; w.x = cvt_pk_bf16(a[0], a[1]); w.y = cvt_pk_bf16(a[2], a[3]); w.z = cvt_pk_bf16(c[0], c[1]); w.w = cvt_pk_bf16(c[2], c[3]);
                        *(u32x4*)(p + bj * 2048) = w; }
                }
        } else {
#pragma unroll
            for (int ai = 0; ai < 2; ++ai)
#pragma unroll
                for (int m = 0; m < 4; ++m) {
                    const int row = u.pm * BM + ai * HALF + wr * 64 + m * 16 + fr;
                    const float rstd = rt.get(u.pm, ai * HALF + wr * 64 + m * 16 + fr);
                    bf16_t* p = Gt + ((size_t)(row >> 5) * 16 + (4 * (pn - 6) + wc)) * 2048 + (row & 31) * 8;
#pragma unroll
                    for (int bj = 0; bj < 2; ++bj) { const f32x4 a = acc[ai][bj][m][0] * rstd, c = acc[ai][bj][m][1] * rstd;
                        u32x4 w; w.x = cvt_pk_bf16(a[0], a[1]); w.y = cvt_pk_bf16(a[2], a[3]); w.z = cvt_pk_bf16(c[0], c[1]); w.w = cvt_pk_bf16(c[2], c[3]);
                        *(u32x4*)(p + (bj * 4 + fq) * 256) = w; }
                }
        }
    }
};
struct EpiBin {
    static constexpr bool PERM = true, AFTER_DRAIN = false;
    bf16_t *Y, *ZH, *CH; RstdTab rt; const float *cw; float* YP;
    __device__ __forceinline__ void operator()(const f32x4 (&acc)[2][2][4][2], const Unit& u, int wr, int wc, int fr, int fq) const {
        const int ch = u.pn * 64 + wc * 16 + fq * 4, lane = fq * 16 + fr;
        const f32x4 w0 = *(const f32x4*)(cw + ch), w1 = *(const f32x4*)(cw + 1024 + ch), w2 = *(const f32x4*)(cw + 2048 + ch);
        const int srcp = (fr == 0) ? lane + 15 : lane - 1, srcn = (fr == 15) ? lane - 15 : lane + 1;
#pragma unroll
        for (int ai = 0; ai < 2; ++ai) {
            f32x4 z[4], s[4];
#pragma unroll
            for (int m = 0; m < 4; ++m) {
                const int row = u.pm * BM + ai * HALF + wr * 64 + m * 16 + fr;
                const float rstd = rt.get(u.pm, ai * HALF + wr * 64 + m * 16 + fr);
                const f32x4 bg = acc[ai][0][m][0] * rstd, cgv = acc[ai][0][m][1] * rstd, uv = acc[ai][1][m][0] * rstd, gt = acc[ai][1][m][1] * rstd;
                z[m] = cgv * uv;
#pragma unroll
                for (int i = 0; i < 4; ++i) s[m][i] = bg[i] * silu_f(gt[i]);
            }
            const int g2 = ((u.pm * BM + ai * HALF + wr * 64) >> 6) * 2;
#pragma unroll
            for (int m = 0; m < 4; ++m) {
                const int row = u.pm * BM + ai * HALF + wr * 64 + m * 16 + fr;
                f32x4 zp, zn;
#pragma unroll
                for (int i = 0; i < 4; ++i) {
                    const float sp = (m > 0 && fr == 15) ? z[m > 0 ? m - 1 : 0][i] : z[m][i];
                    const float a = __shfl(sp, srcp);
                    zp[i] = (m == 0 && fr == 0) ? 0.f : a;
                    const float sn = (m < 3 && fr == 0) ? z[m < 3 ? m + 1 : 3][i] : z[m][i];
                    const float b = __shfl(sn, srcn);
                    zn[i] = (m == 3 && fr == 15) ? 0.f : b;
                }
                const f32x4 y = s[m] * (w0 * zp + w1 * z[m] + w2 * zn);
                u32x2 wy; wy.x = cvt_pk_bf16(y[0], y[1]); wy.y = cvt_pk_bf16(y[2], y[3]);
                *(u32x2*)(Y + (size_t)row * 1024 + ch) = wy;
                if (m == 0 && fr == 0) { const f32x4 c = s[0] * w0; u32x2 a, b; a.x = cvt_pk_bf16(z[0][0], z[0][1]); a.y = cvt_pk_bf16(z[0][2], z[0][3]); b.x = cvt_pk_bf16(c[0], c[1]); b.y = cvt_pk_bf16(c[2], c[3]);
                    *(u32x2*)(ZH + (size_t)g2 * 1024 + ch) = a; *(u32x2*)(CH + (size_t)g2 * 1024 + ch) = b; *(f32x4*)(YP + (size_t)g2 * 1024 + ch) = y; }
                if (m == 3 && fr == 15) { const f32x4 c = s[3] * w2; u32x2 a, b; a.x = cvt_pk_bf16(z[3][0], z[3][1]); a.y = cvt_pk_bf16(z[3][2], z[3][3]); b.x = cvt_pk_bf16(c[0], c[1]); b.y = cvt_pk_bf16(c[2], c[3]);
                    *(u32x2*)(ZH + (size_t)(g2 + 1) * 1024 + ch) = a; *(u32x2*)(CH + (size_t)(g2 + 1) * 1024 + ch) = b; *(f32x4*)(YP + (size_t)(g2 + 1) * 1024 + ch) = y; }
            }
        }
    }
};
struct EpiOut {
    static constexpr bool PERM = true, AFTER_DRAIN = false;
    bf16_t* xb; float* ss; float* fout;
    __device__ __forceinline__ void operator()(const f32x4 (&acc)[2][2][4][2], const Unit& u, int wr, int wc, int fr, int fq) const {
#pragma unroll
        for (int ai = 0; ai < 2; ++ai)
#pragma unroll
            for (int m = 0; m < 4; ++m) {
                const int row = u.pm * BM + ai * HALF + wr * 64 + m * 16 + fr;
                const size_t off = (size_t)row * 1024 + u.pn * BM + wc * 32 + 8 * fq;
                float sq = 0.f;
                u32x4 xw[2];
#pragma unroll
                for (int bj = 0; bj < 2; ++bj) xw[bj] = *(const u32x4*)(xb + off + bj * HALF);
#pragma unroll
                for (int bj = 0; bj < 2; ++bj) {
                    const f32x4 x0 = {bf_lo(xw[bj].x), bf_hi(xw[bj].x), bf_lo(xw[bj].y), bf_hi(xw[bj].y)}, x1 = {bf_lo(xw[bj].z), bf_hi(xw[bj].z), bf_lo(xw[bj].w), bf_hi(xw[bj].w)};
                    const f32x4 o0 = x0 + acc[ai][bj][m][0], o1 = x1 + acc[ai][bj][m][1];
                    if (fout) { __builtin_nontemporal_store(o0, (f32x4*)(fout + off + bj * HALF)); __builtin_nontemporal_store(o1, (f32x4*)(fout + off + bj * HALF + 4)); }
                    else {
                        u32x4 w; w.x = cvt_pk_bf16(o0[0], o0[1]); w.y = cvt_pk_bf16(o0[2], o0[3]); w.z = cvt_pk_bf16(o1[0], o1[1]); w.w = cvt_pk_bf16(o1[2], o1[3]);
                        *(u32x4*)(xb + off + bj * HALF) = w;
                        const f32x4 q0 = o0 * o0, q1 = o1 * o1; sq += ((q0[0] + q0[1]) + (q0[2] + q0[3])) + ((q1[0] + q1[1]) + (q1[2] + q1[3]));
                    }
                }
                if (!fout) { sq += __shfl_xor(sq, 16); sq += __shfl_xor(sq, 32); if (fq == 0) ss[(size_t)row * 16 + u.pn * 4 + wc] = sq; }
            }
    }
};
}

typedef LAS const char* lds_cptr;
typedef short v4i16_t __attribute__((ext_vector_type(4)));
__device__ __forceinline__ v4i16_t vtr(lds_cptr p) { return __builtin_amdgcn_ds_read_tr16_b64_v4i16((LAS v4i16_t*)p); }
#define MFMA32(a, b, c) __builtin_amdgcn_mfma_f32_32x32x16_bf16((a), (b), (c), 0, 0, 0)

__device__ __forceinline__ void attn_dma_block(LAS unsigned char* lds, const bf16_t* __restrict__ Kg, const bf16_t* __restrict__ Vg, int bkh, int blk, int wid, int lane) {
    const int slot = blk & 3;
#pragma unroll
    for (int t = 0; t < 2; ++t) {
        const size_t goff = (size_t)(bkh * 32 + 2 * blk + t) * 4096 + wid * 512 + lane * 8;
        LAS unsigned char* kd = lds + slot * 16384 + t * 8192 + wid * 1024;
        __builtin_amdgcn_global_load_lds((const unsigned*)(Kg + goff), (LAS unsigned*)kd, 16, 0, KV_AUX);
        __builtin_amdgcn_global_load_lds((const unsigned*)(Vg + goff), (LAS unsigned*)(kd + 65536), 16, 0, KV_AUX);
    }
}
__device__ __forceinline__ void attn_phase(LAS unsigned char* lds, const bf16_t* __restrict__ Q, const bf16_t* __restrict__ Kg, const bf16_t* __restrict__ Vg,
                                           const bf16_t* __restrict__ Gt, bf16_t* __restrict__ OG, const float* __restrict__ sink, float shift2, int c0, int G) {
    int tid_ = threadIdx.x; asm volatile("" : "+v"(tid_));
    const int tid = tid_, lane = tid & 63, wid = __builtin_amdgcn_readfirstlane(tid >> 6), r = lane & 31, h = lane >> 5;
    const int par = wid & 1, gh = wid >> 1, qoff = par * 64;
    const int voff = (4 * h + ((lane & 15) >> 2)) * 64 + ((lane >> 4) & 1) * 32 + (lane & 3) * 8;
    v16f negs;
#pragma unroll
    for (int i = 0; i < 16; ++i) negs[i] = -shift2;
    asm volatile("" : "+v"(negs));
    if (wid >= 4) __builtin_amdgcn_s_setprio(1);
    for (int su = c0; su < BATCH * 4 * 4; su += G) {
        const int bkh = su >> 2, b = bkh >> 2, kh = bkh & 3, n0 = (su & 3) * 4;
        const int head = kh * 4 + gh;
        if (n0 > 0) attn_dma_block(lds, Kg, Vg, bkh, n0 - 1, wid, lane);
        attn_dma_block(lds, Kg, Vg, bkh, n0, wid, lane);
        attn_dma_block(lds, Kg, Vg, bkh, n0 + 1, wid, lane);
        s8x qf[2][4];
#pragma unroll
        for (int qs = 0; qs < 2; ++qs)
#pragma unroll
            for (int ds = 0; ds < 4; ++ds) qf[qs][ds] = __builtin_nontemporal_load((const s8x*)(Q + ((size_t)((b * SEQ + n0 * 128 + qoff + 32 * qs) >> 5) * 16 + head) * 2048 + ((2 * ds + h) * 32 + r) * 8));
        asm volatile("s_waitcnt vmcnt(0)" ::: "memory");
        __syncthreads();
#pragma unroll 1
        for (int n = n0; n < n0 + 4; ++n) {
            const int kt0 = (n == 0) ? 2 : 0, kt1 = (n == 15) ? 4 : 6;
            const int row0 = b * SEQ + n * 128 + qoff;
            if (n < n0 + 3 && n + 2 <= 15) attn_dma_block(lds, Kg, Vg, bkh, n + 2, wid, lane);
            v16f o[2][2];
#pragma unroll
            for (int a = 0; a < 2; ++a)
#pragma unroll
                for (int c = 0; c < 2; ++c)
#pragma unroll
                    for (int i = 0; i < 16; ++i) o[a][c][i] = 0.f;
            float l0 = 0.f, l1 = 0.f;
            const int wlo = kt0 > par ? kt0 : par, whi = kt1 < 5 + par ? kt1 : 5 + par;
            v2u gwv[2][2][4];
#ifndef REP_ATTLOOP
#define REP_ATTLOOP 1
#endif
_Pragma("unroll 1")
            for (int rep_ = 0; rep_ < REP_ATTLOOP; ++rep_) {
            const int s0 = 2 * wlo, s1 = 2 * whi;
#define ATT_KADDR(stp) ((lds_cptr)lds + ((n - 1 + ((stp) >> 2)) & 3) * 16384 + (((stp) >> 1) & 1) * 8192 + h * 1024 + (32 * ((stp) & 1) + r) * 16)
#define ATT_VADDR(stp) ((lds_cptr)lds + 65536 + ((n - 1 + ((stp) >> 2)) & 3) * 16384 + (((stp) >> 1) & 1) * 8192 + ((stp) & 1) * 2048 + voff)
#define ATT_MASK(stp, A0, A1) do { const int kt_ = (stp) >> 1; if ((kt_ == par) || (kt_ == 4 + par)) { asm volatile("" ::: "memory"); \
                const int cb = 32 * (stp) + 4 * h, iq0 = qoff + r, iq1 = iq0 + 32; \
                _Pragma("unroll") for (int i = 0; i < 16; ++i) { const int c = cb + (i & 3) + 8 * (i >> 2); \
                    if (!(c >= iq0 && c <= iq0 + 256)) A0[i] = -INFINITY; if (!(c >= iq1 && c <= iq1 + 256)) A1[i] = -INFINITY; } } } while (0)
#define ATT_EXP_PACK(A0, A1, PK) do { _Pragma("unroll") for (int i = 0; i < 16; ++i) { A0[i] = __builtin_amdgcn_exp2f(A0[i]); A1[i] = __builtin_amdgcn_exp2f(A1[i]); l0 += A0[i]; l1 += A1[i]; } \
                _Pragma("unroll") for (int s = 0; s < 2; ++s) _Pragma("unroll") for (int j = 0; j < 4; ++j) { PK[s][0][j] = pk_bf16(A0[8 * s + 2 * j], A0[8 * s + 2 * j + 1]); PK[s][1][j] = pk_bf16(A1[8 * s + 2 * j], A1[8 * s + 2 * j + 1]); } } while (0)
            s8x kfr[4]; v4u pcur[2][2];
            {   const lds_cptr kp = ATT_KADDR(s0);
#pragma unroll
                for (int ds = 0; ds < 4; ++ds) kfr[ds] = *(const LAS s8x*)(kp + ds * 2048);
                v16f st0 = negs, st1 = negs;
#pragma unroll
                for (int ds = 0; ds < 4; ++ds) { st0 = MFMA32(kfr[ds], qf[0][ds], st0); st1 = MFMA32(kfr[ds], qf[1][ds], st1); }
                const lds_cptr kp2 = ATT_KADDR(s0 + 1 < s1 ? s0 + 1 : s0);
#pragma unroll
                for (int ds = 0; ds < 4; ++ds) kfr[ds] = *(const LAS s8x*)(kp2 + ds * 2048);
                ATT_MASK(s0, st0, st1);
                ATT_EXP_PACK(st0, st1, pcur);
            }
#pragma unroll 1
            for (int step = s0; step < s1 - 1; ++step) {
                s8x vf[2][2];
                {   const lds_cptr vp = ATT_VADDR(step);
#pragma unroll
                    for (int s = 0; s < 2; ++s)
#pragma unroll
                        for (int dblk = 0; dblk < 2; ++dblk) { const v4i16_t lo = vtr(vp + dblk * 4096 + s * 1024), hi = vtr(vp + dblk * 4096 + s * 1024 + 512); vf[s][dblk] = __builtin_shufflevector(lo, hi, 0, 1, 2, 3, 4, 5, 6, 7); } }
                v16f st0 = negs, st1 = negs;
#pragma unroll
                for (int ds = 0; ds < 4; ++ds) { st0 = MFMA32(kfr[ds], qf[0][ds], st0); st1 = MFMA32(kfr[ds], qf[1][ds], st1); }
                {   const lds_cptr kp = ATT_KADDR(step + 2 < s1 ? step + 2 : step + 1);
#pragma unroll
                    for (int ds = 0; ds < 4; ++ds) kfr[ds] = *(const LAS s8x*)(kp + ds * 2048); }
                ATT_MASK(step + 1, st0, st1);
                __builtin_amdgcn_sched_barrier(0);
                v4u pnext[2][2];
#pragma unroll
                for (int s = 0; s < 2; ++s)
#pragma unroll
                    for (int dblk = 0; dblk < 2; ++dblk) { o[dblk][0] = MFMA32(vf[s][dblk], __builtin_bit_cast(s8x, pcur[s][0]), o[dblk][0]); o[dblk][1] = MFMA32(vf[s][dblk], __builtin_bit_cast(s8x, pcur[s][1]), o[dblk][1]); }
                ATT_EXP_PACK(st0, st1, pnext);
#pragma unroll
                for (int k = 0; k < 8; ++k) { __builtin_amdgcn_sched_group_barrier(0x008, 1, 0); __builtin_amdgcn_sched_group_barrier(0x002, 11, 0); }
                __builtin_amdgcn_sched_barrier(0);
#pragma unroll
                for (int s = 0; s < 2; ++s) { pcur[s][0] = pnext[s][0]; pcur[s][1] = pnext[s][1]; }
            }
            if (n < n0 + 3) {
#pragma unroll
                for (int qs = 0; qs < 2; ++qs)
#pragma unroll
                    for (int ds = 0; ds < 4; ++ds) qf[qs][ds] = __builtin_nontemporal_load((const s8x*)(Q + ((size_t)((row0 + 128 + 32 * qs) >> 5) * 16 + head) * 2048 + ((2 * ds + h) * 32 + r) * 8));
            }
#pragma unroll
            for (int qs = 0; qs < 2; ++qs)
#pragma unroll
                for (int dblk = 0; dblk < 2; ++dblk)
#pragma unroll
                    for (int gi = 0; gi < 4; ++gi) gwv[qs][dblk][gi] = __builtin_nontemporal_load((const v2u*)(Gt + ((size_t)((row0 + 32 * qs) >> 5) * 16 + head) * 2048 + r * 8 + h * 4 + (dblk * 4 + gi) * 256));
            {
                const lds_cptr vp = ATT_VADDR(s1 - 1);
#pragma unroll
                for (int s = 0; s < 2; ++s)
#pragma unroll
                    for (int dblk = 0; dblk < 2; ++dblk) { const v4i16_t lo = vtr(vp + dblk * 4096 + s * 1024), hi = vtr(vp + dblk * 4096 + s * 1024 + 512); const s8x vfr = __builtin_shufflevector(lo, hi, 0, 1, 2, 3, 4, 5, 6, 7);
                        o[dblk][0] = MFMA32(vfr, __builtin_bit_cast(s8x, pcur[s][0]), o[dblk][0]); o[dblk][1] = MFMA32(vfr, __builtin_bit_cast(s8x, pcur[s][1]), o[dblk][1]); }
            }
            }
#undef ATT_KADDR
#undef ATT_VADDR
#undef ATT_MASK
#undef ATT_EXP_PACK
            asm volatile("s_waitcnt vmcnt(0)" ::: "memory");
            __syncthreads();
            l0 += __shfl_xor(l0, 32); l1 += __shfl_xor(l1, 32);
            const float sk = (float)REP_ATTLOOP * __builtin_amdgcn_exp2f(sink[head] * LOG2E - shift2);
            const float inv0 = 1.f / (l0 + sk), inv1 = 1.f / (l1 + sk);
#pragma unroll
            for (int qs = 0; qs < 2; ++qs) {
                bf16_t* op = OG + (size_t)(row0 + 32 * qs + r) * 1024 + head * 64 + h * 32;
                const float inv = qs ? inv1 : inv0;
#pragma unroll
                for (int dblk = 0; dblk < 2; ++dblk) {
                    unsigned w[8];
#pragma unroll
                    for (int gi = 0; gi < 4; ++gi) {
                        const float a0 = o[dblk][qs][4 * gi] * inv * silu_f(bf_lo(gwv[qs][dblk][gi].x)), a1 = o[dblk][qs][4 * gi + 1] * inv * silu_f(bf_hi(gwv[qs][dblk][gi].x));
                        const float a2 = o[dblk][qs][4 * gi + 2] * inv * silu_f(bf_lo(gwv[qs][dblk][gi].y)), a3 = o[dblk][qs][4 * gi + 3] * inv * silu_f(bf_hi(gwv[qs][dblk][gi].y));
                        w[2 * gi] = pk_bf16(a0, a1); w[2 * gi + 1] = pk_bf16(a2, a3);
                    }
                    *(v4u*)(op + dblk * 16) = (v4u){w[0], w[1], w[2], w[3]}; *(v4u*)(op + dblk * 16 + 8) = (v4u){w[4], w[5], w[6], w[7]};
                }
            }
        }
    }
    __builtin_amdgcn_s_setprio(0);
}

__device__ __forceinline__ void unpack8(const v4u w, float (&f)[8]) { f[0] = bf_lo(w.x); f[1] = bf_hi(w.x); f[2] = bf_lo(w.y); f[3] = bf_hi(w.y); f[4] = bf_lo(w.z); f[5] = bf_hi(w.z); f[6] = bf_lo(w.w); f[7] = bf_hi(w.w); }
template <class Sched> __device__ __forceinline__ void conv_fix_tiles(const Sched& S, bf16_t* __restrict__ Y, const float* __restrict__ YP, const bf16_t* __restrict__ ZH, const bf16_t* __restrict__ CH) {
    int tid_ = threadIdx.x; asm volatile("" : "+v"(tid_));
    const int tid = tid_;
    pg8::Unit u;
    for (int i = 0; S.next(i, u); ++i) {
#pragma unroll
        for (int w = tid; w < 1024; w += 512) {
            const int rowi = w >> 7, g = 4 * u.pm + (rowi >> 1), side = rowi & 1, ch = (w & 127) * 8;
            const int t = 64 * g + (side ? 63 : 0);
            const bool has = side ? (((t + 1) & (SEQ - 1)) != 0) : ((t & (SEQ - 1)) != 0);
            const v4f y0 = *(const v4f*)(YP + (size_t)(2 * g + side) * 1024 + ch), y1 = *(const v4f*)(YP + (size_t)(2 * g + side) * 1024 + ch + 4);
            float y[8] = {y0[0], y0[1], y0[2], y0[3], y1[0], y1[1], y1[2], y1[3]};
            if (has) {
                const v4u cwv = *(const v4u*)(CH + (size_t)(2 * g + side) * 1024 + ch);
                const v4u zw = *(const v4u*)(ZH + (size_t)(side ? 2 * (g + 1) : 2 * (g - 1) + 1) * 1024 + ch);
                float c[8], z[8]; unpack8(cwv, c); unpack8(zw, z);
#pragma unroll
                for (int k = 0; k < 8; ++k) y[k] += c[k] * z[k];
            }
            v4u o; o.x = pk_bf16(y[0], y[1]); o.y = pk_bf16(y[2], y[3]); o.z = pk_bf16(y[4], y[5]); o.w = pk_bf16(y[6], y[7]);
            *(v4u*)(Y + (size_t)t * 1024 + ch) = o;
        }
    }
    asm volatile("s_waitcnt vmcnt(0)" ::: "memory");
    __syncthreads();
}

__device__ __forceinline__ int dst_row(int kind, int j) {
    if (kind == 0) return j;
    if (kind == 1) { const int pn = j >> 8, jj = j & 255, head = jj >> 6, d = jj & 63; return pn * 256 + (d >> 5) * 128 + head * 32 + (d & 31); }
    const int knd = j >> 10, chan = j & 1023, pn = chan >> 6, cl = chan & 63, wc = cl >> 4, fq = (cl >> 2) & 3, i = cl & 3;
    return pn * 256 + (knd >> 1) * 128 + wc * 32 + fq * 8 + (knd & 1) * 4 + i;
}
__device__ __forceinline__ int kperm_og(int kp) { const int p = kp & 63, hh = p >> 5, dblk = (p >> 4) & 1, i = p & 15; return (kp & ~63) | (32 * dblk + 8 * (i >> 2) + 4 * hh + (i & 3)); }
__device__ __forceinline__ void transpose_block(const float* __restrict__ W, int K, int N, bf16_t* __restrict__ WT, int kind, const float* __restrict__ g, LAS float* T, int item, int tid, bool kp) {
    const int nblk = N / 256, kb = item / nblk, nb = item % nblk, k0 = 64 * kb, n0 = 256 * nb;
    constexpr int P = 257;
#pragma unroll
    for (int i = 0; i < 8; ++i) {
        const int q = tid + 512 * i, kk = q >> 6, c4 = q & 63;
        const int ks = kp ? kperm_og(k0 + kk) : (k0 + kk);
        v4f w = __builtin_nontemporal_load((const v4f*)(W + (size_t)ks * N + n0 + 4 * c4));
        if (g) w = w * g[ks];
        LAS float* t = T + kk * P + 4 * c4;
        t[0] = w[0]; t[1] = w[1]; t[2] = w[2]; t[3] = w[3];
    }
    __syncthreads();
#pragma unroll
    for (int j = 0; j < 4; ++j) {
        const int o = tid + 512 * j, c = o & 7, n = o >> 3;
        const LAS float* t = T + (8 * c) * P + n;
        v4u ov; ov.x = pk_bf16(t[0], t[P]); ov.y = pk_bf16(t[2 * P], t[3 * P]); ov.z = pk_bf16(t[4 * P], t[5 * P]); ov.w = pk_bf16(t[6 * P], t[7 * P]);
        *(v4u*)(WT + (size_t)dst_row(kind, n0 + n) * K + k0 + 8 * c) = ov;
    }
    __syncthreads();
}

#define XB_TMO      128
#define XB_XCNT(j)  (256  + 64 * (j))
#define XB_XSUB(j)  (1280 + 64 * (j))
#define XB_XGEN(j)  (2304 + 64 * (j))
#define XB_TOP      3328
#define XB_TOPGEN   3392
#define XCD_BAR_WORDS 3456
#define XB_SPIN_CAP (1u << 18)

__device__ __forceinline__ unsigned xb_ld(unsigned* p)              { return __hip_atomic_load(p, __ATOMIC_RELAXED, __HIP_MEMORY_SCOPE_AGENT); }
__device__ __forceinline__ unsigned xb_add(unsigned* p, unsigned v) { return __hip_atomic_fetch_add(p, v, __ATOMIC_RELAXED, __HIP_MEMORY_SCOPE_AGENT); }
__device__ __forceinline__ unsigned xb_xcc_id() { return (unsigned)__builtin_amdgcn_s_getreg((3 << 11) | 20) & 0xFu; }
#define XB_SPIN(cond, bar) do { unsigned _sp = 0; while (cond) { __builtin_amdgcn_s_sleep(1); \
    if ((++_sp & 255u) == 0u) { if (xb_ld(&(bar)[XB_TMO])) break; if (_sp > XB_SPIN_CAP) { atomicAdd(&(bar)[XB_TMO], 1u); break; } } } } while (0)

struct XcdBarrier {
    unsigned* bar; unsigned x;
    volatile LAS unsigned* st;
};

__device__ __forceinline__ XcdBarrier xcd_barrier_post(unsigned* bar, volatile LAS unsigned* st) {
    XcdBarrier b; b.bar = bar; b.x = xb_xcc_id(); b.st = st;
    if (threadIdx.x == 0) (void)xb_add(&bar[XB_XCNT(b.x)], 1u);
    return b;
}
__device__ __forceinline__ void xcd_barrier_complete(unsigned* bar, unsigned x, unsigned& nloc, unsigned& nx) {
    const unsigned G = gridDim.x * gridDim.y * gridDim.z;
    unsigned sum, cnt, mine, sp = 0u;
    for (;;) {
        sum = 0u; cnt = 0u; mine = 0u;
#pragma unroll
        for (unsigned j = 0; j < 16; ++j) { const unsigned c = xb_ld(&bar[XB_XCNT(j)]); sum += c; cnt += (c > 0u) ? 1u : 0u; mine = (j == x) ? c : mine; }
        if (sum == G) break;
        __builtin_amdgcn_s_sleep(1);
        if ((++sp & 255u) == 0u) { if (xb_ld(&bar[XB_TMO])) break; if (sp > XB_SPIN_CAP) { atomicAdd(&bar[XB_TMO], 1u); break; } }
    }
    nloc = mine > 0u ? mine : 1u; nx = cnt > 0u ? cnt : 1u;
}

__device__ __forceinline__ void xcd_barrier(const XcdBarrier& b) {
    asm volatile("s_waitcnt vmcnt(0)" ::: "memory");
    __syncthreads();
    if (threadIdx.x == 0) {
        unsigned* bar = b.bar;
        __builtin_amdgcn_s_waitcnt(0);
        unsigned nloc = b.st[0], nx = b.st[1];
        if (nloc == 0u) { xcd_barrier_complete(bar, b.x, nloc, nx); b.st[0] = nloc; b.st[1] = nx; }
        const unsigned old = xb_add(&bar[XB_XSUB(b.x)], 1u);
        const unsigned gen = old / nloc;
        if (old + 1u == (gen + 1u) * nloc) {
            __builtin_amdgcn_fence(__ATOMIC_RELEASE, "agent");
            asm volatile("s_waitcnt vmcnt(0)" ::: "memory");
            const unsigned og = xb_add(&bar[XB_TOP], 1u);
            const unsigned tg = og / nx;
            if (og + 1u == (tg + 1u) * nx) xb_add(&bar[XB_TOPGEN], 1u);
            else XB_SPIN(xb_ld(&bar[XB_TOPGEN]) == tg, bar);
            __builtin_amdgcn_fence(__ATOMIC_ACQUIRE, "agent");
            xb_add(&bar[XB_XGEN(b.x)], 1u);
            asm volatile("s_waitcnt vmcnt(0)" ::: "memory");
        } else {
            XB_SPIN(xb_ld(&bar[XB_XGEN(b.x)]) == gen, bar);
            __builtin_amdgcn_fence(__ATOMIC_ACQUIRE, "agent");
            asm volatile("s_waitcnt vmcnt(0)" ::: "memory");
        }
    }
    __syncthreads();
}

constexpr size_t MiB = 1u << 20;
constexpr size_t WS_COS = 1 * MiB, WS_SIN = WS_COS + 256 * 1024;
constexpr size_t WS_SS = 2 * MiB;
constexpr size_t WS_WAIN = 4 * MiB, WS_WAOUT = 14 * MiB, WS_WBIN = 18 * MiB, WS_WBOUT = 34 * MiB;
constexpr size_t WS_XB = 40 * MiB;
constexpr size_t WS_Q = 104 * MiB;
constexpr size_t WS_G = 168 * MiB;
constexpr size_t WS_K = 232 * MiB, WS_V = 248 * MiB;
constexpr size_t WS_OG = 264 * MiB;
constexpr size_t WS_END = 328 * MiB;
constexpr int LDS_BYTES = 135168;

template <class Sched> __device__ __forceinline__ pg8::RstdTab rstd_table_fill(const Sched& S, LAS float* tab, const float* ss) {
    int tid_ = threadIdx.x; asm volatile("" : "+v"(tid_));
    const int tid = tid_;
    pg8::Unit u; int pm0 = -1, pm1 = -1;
    for (int i = 0; S.next(i, u); ++i) { if (pm0 < 0) pm0 = u.pm; else if (u.pm != pm0 && pm1 < 0) pm1 = u.pm; }
    const int pm = (tid < 256) ? pm0 : pm1;
    if (pm >= 0) tab[tid] = pg8::row_rstd(ss, pm * 256 + (tid & 255));
    __syncthreads();
    return pg8::RstdTab{tab, pm0, pm1, ss};
}
#ifndef REP_P0
#define REP_P0 1
#endif
#ifndef REP_OUTX
#define REP_OUTX 0
#endif
#ifndef REP_AIN
#define REP_AIN 1
#endif
#ifndef REP_ATTN
#define REP_ATTN 1
#endif
#ifndef REP_AOUT0
#define REP_AOUT0 1
#endif
#ifndef REP_BIN
#define REP_BIN 1
#endif
#ifndef REP_CONV
#define REP_CONV 1
#endif
#ifndef GEMM_ALIGN
#define GEMM_ALIGN true
#endif
#ifndef GEMM_SP2
#define GEMM_SP2 true
#endif
struct Args { const float* in[10]; float* out; unsigned char* ws; int ph_lo, ph_hi; };
constexpr int N_PHASES = 13;

__global__ void __launch_bounds__(512, 2) fwd_kernel(Args args) {
    extern __shared__ __attribute__((aligned(16))) unsigned char lds_raw[];
    LAS unsigned char* lds = (LAS unsigned char*)lds_raw;
    cg::grid_group grid = cg::this_grid();
    const int tid = threadIdx.x, lane = tid & 63, wave = __builtin_amdgcn_readfirstlane(tid >> 6);
    const int G = gridDim.x, bx = blockIdx.x;
    unsigned char* ws = args.ws;
    const float* x_in = args.in[0]; const float* norm_g = args.in[1]; const float* a_w_in = args.in[2]; const float* a_qn = args.in[3]; const float* a_kn = args.in[4];
    const float* a_sink = args.in[5]; const float* a_w_out = args.in[6]; const float* b_w_in = args.in[7]; const float* b_conv = args.in[8]; const float* b_w_out = args.in[9];
    float* out = args.out;
    float* cosT = (float*)(ws + WS_COS); float* sinT = (float*)(ws + WS_SIN); float* ss = (float*)(ws + WS_SS);
    bf16_t* XB = (bf16_t*)(ws + WS_XB); bf16_t* QB = (bf16_t*)(ws + WS_Q); bf16_t* GB = (bf16_t*)(ws + WS_G); bf16_t* KB = (bf16_t*)(ws + WS_K); bf16_t* VB = (bf16_t*)(ws + WS_V); bf16_t* OGB = (bf16_t*)(ws + WS_OG);
    const int lo = args.ph_lo, hi = args.ph_hi;
#define IN(k) (lo <= (k) && (k) < hi)
#ifdef SEAM_X3
#define SEAM(k) do { if (IN(k) && IN((k) + 1)) { xcd_barrier(bar); xcd_barrier(bar); xcd_barrier(bar); } } while (0)
#else
#define SEAM(k) do { if (IN(k) && IN((k) + 1)) xcd_barrier(bar); } while (0)
#endif
    if (args.ph_lo < 0) grid.sync();
    if (tid < 16) ((LAS unsigned*)(lds + 131072))[tid] = 0u;
    __syncthreads();
    XcdBarrier bar = xcd_barrier_post((unsigned*)ws, (volatile LAS unsigned*)(lds + 131072) + 8);

#ifndef NO_P0
    if (IN(0))
_Pragma("unroll 1")
    for (int rep = 0; rep < REP_P0; ++rep) {
        const int gw = bx * 8 + wave, NGW = G * 8;
        {
            LAS float* T = (LAS float*)lds;
            constexpr int I_AIN = 16 * (A_IN / 256), I_OUT = 16 * 4, I_BIN = 16 * (B_IN / 256);
            constexpr int PER_PAIR = I_AIN + I_OUT + I_BIN + I_OUT;
            int tid_ = threadIdx.x; asm volatile("" : "+v"(tid_));
            for (int it = bx; it < 2 * PER_PAIR; it += G) {
                const int sl = it / PER_PAIR; int rr = it % PER_PAIR;
                if (rr < I_AIN) { transpose_block(a_w_in + (size_t)sl * DM * A_IN, DM, A_IN, (bf16_t*)(ws + WS_WAIN) + (size_t)sl * DM * A_IN, 1, norm_g + (2 * sl) * DM, T, rr, tid_, false); continue; } rr -= I_AIN;
                if (rr < I_OUT) { transpose_block(a_w_out + (size_t)sl * DM * DM, DM, DM, (bf16_t*)(ws + WS_WAOUT) + (size_t)sl * DM * DM, 0, nullptr, T, rr, tid_, true); continue; } rr -= I_OUT;
                if (rr < I_BIN) { transpose_block(b_w_in + (size_t)sl * DM * B_IN, DM, B_IN, (bf16_t*)(ws + WS_WBIN) + (size_t)sl * DM * B_IN, 2, norm_g + (2 * sl + 1) * DM, T, rr, tid_, false); continue; } rr -= I_BIN;
                transpose_block(b_w_out + (size_t)sl * DM * DM, DM, DM, (bf16_t*)(ws + WS_WBOUT) + (size_t)sl * DM * DM, 0, nullptr, T, rr, tid_, false);
            }
        }
        for (int idx = bx * 512 + tid; idx < SEQ * 32; idx += G * 512) {
            const int t = idx >> 5, f = idx & 31;
            const float inv_freq = __builtin_amdgcn_exp2f(-(float)f * (13.287712379549449f / 32.f));
            const float ang = (float)t * inv_freq;
            double rv = (double)ang * 0.15915494309189535; rv -= __builtin_rint(rv);
            const float fr = (float)rv;
            cosT[idx] = __builtin_amdgcn_cosf(fr); sinT[idx] = __builtin_amdgcn_sinf(fr);
        }
        for (int m0 = gw; m0 < MTOK; m0 += 4 * NGW) {
            v4f v[4][4]; float s[4];
#pragma unroll
            for (int q = 0; q < 4; ++q) { const int m = m0 + q * NGW; if (m < MTOK) { const v4f* xr = (const v4f*)(x_in + (size_t)m * DM) + lane;
#pragma unroll
                for (int j = 0; j < 4; ++j) v[q][j] = __builtin_nontemporal_load(xr + 64 * j); } }
#pragma unroll
            for (int q = 0; q < 4; ++q) { const int m = m0 + q * NGW; if (m < MTOK) {
                s[q] = 0.f;
#pragma unroll
                for (int j = 0; j < 4; ++j) s[q] += (v[q][j][0] * v[q][j][0] + v[q][j][1] * v[q][j][1]) + (v[q][j][2] * v[q][j][2] + v[q][j][3] * v[q][j][3]);
#pragma unroll
                for (int o = 1; o < 64; o <<= 1) s[q] += __shfl_xor(s[q], o);
                v2u* o8 = (v2u*)(XB + (size_t)m * DM) + lane;
#pragma unroll
                for (int j = 0; j < 4; ++j) { v2u w; w.x = pk_bf16(v[q][j][0], v[q][j][1]); w.y = pk_bf16(v[q][j][2], v[q][j][3]); o8[64 * j] = w; }
                if (lane < 16) ss[(size_t)m * 16 + lane] = (lane == 0) ? s[q] : 0.f; } }
        }
    }
#endif
    SEAM(0);

#pragma unroll 1
    for (int L = 0; L < 4; ++L) {
        const int sl = L >> 1, p0 = 1 + 3 * L;
        if ((L & 1) == 0) {
            if (IN(p0)) {
                pg8::Gemm g{XB, (const bf16_t*)(ws + WS_WAIN) + (size_t)sl * DM * A_IN, MTOK, A_IN, DM};
                pg8::StaticOrder S; S.init(MTOK, A_IN, G, bx);
                const pg8::RstdTab rt = rstd_table_fill(S, (LAS float*)(lds + 131072 + 256), ss);
                pg8::EpiAin E{QB, KB, VB, GB, rt, a_qn + sl * 64, a_kn + sl * 64, cosT, sinT};
#ifndef NO_AIN
_Pragma("unroll 1")
                for (int rep = 0; rep < REP_AIN; ++rep) pg8::gemm_phase<pg8::EpiAin, pg8::StaticOrder, GEMM_ALIGN, GEMM_SP2>(lds, g, S, E);
#endif
            }
            SEAM(p0);
            if (IN(p0 + 1)) {
                float mq = fabsf(a_qn[sl * 64 + lane]), mk = fabsf(a_kn[sl * 64 + lane]);
#pragma unroll
                for (int o = 1; o < 64; o <<= 1) { mq = fmaxf(mq, __shfl_xor(mq, o)); mk = fmaxf(mk, __shfl_xor(mk, o)); }
                const float shift2 = 11.7f * mq * mk;
#ifndef NO_ATTN
_Pragma("unroll 1")
                for (int rep = 0; rep < REP_ATTN; ++rep) attn_phase(lds, QB, KB, VB, GB, OGB, a_sink + sl * 16, shift2, bx, G);
#endif
            }
            SEAM(p0 + 1);
            if (IN(p0 + 2)) {
                pg8::Gemm g{OGB, (const bf16_t*)(ws + WS_WAOUT) + (size_t)sl * DM * DM, MTOK, DM, DM};
                pg8::StaticOrder S; S.init(MTOK, DM, G, bx);
                pg8::EpiOut E{XB, ss, (L == 3) ? out : nullptr};
                if (REP_OUTX) { pg8::EpiOut E2{QB, (float*)(ws + WS_K), nullptr};
_Pragma("unroll 1")
                    for (int rep = 0; rep < REP_OUTX; ++rep) pg8::gemm_phase<pg8::EpiOut, pg8::StaticOrder, GEMM_ALIGN, GEMM_SP2>(lds, g, S, E2); }
#ifndef NO_OUT
_Pragma("unroll 1")
                for (int rep = 0; rep < ((L == 0) ? REP_AOUT0 : 1); ++rep) pg8::gemm_phase<pg8::EpiOut, pg8::StaticOrder, GEMM_ALIGN, GEMM_SP2, OUT_A_AUX>(lds, g, S, E);
#endif
            }
            SEAM(p0 + 2);
        } else {
            if (IN(p0)) {
                pg8::Gemm g{XB, (const bf16_t*)(ws + WS_WBIN) + (size_t)sl * DM * B_IN, MTOK, B_IN, DM};
                pg8::StaticOrder S; S.init(MTOK, B_IN, G, bx);
                const pg8::RstdTab rt = rstd_table_fill(S, (LAS float*)(lds + 131072 + 256), ss);
                pg8::EpiBin E{OGB, KB, KB + (size_t)1024 * 1024, rt, b_conv + sl * 3 * DM, (float*)(ws + WS_V)};
#ifndef NO_BIN
_Pragma("unroll 1")
                for (int rep = 0; rep < REP_BIN; ++rep) pg8::gemm_phase<pg8::EpiBin, pg8::StaticOrder, GEMM_ALIGN, GEMM_SP2>(lds, g, S, E);
#endif
            }
            SEAM(p0);
            if (IN(p0 + 2)) {
                pg8::Gemm g{OGB, (const bf16_t*)(ws + WS_WBOUT) + (size_t)sl * DM * DM, MTOK, DM, DM};
                pg8::StaticOrder S; S.init(MTOK, DM, G, bx);
                conv_fix_tiles(S, OGB, (const float*)(ws + WS_V), KB, KB + (size_t)1024 * 1024);
                pg8::EpiOut E{XB, ss, (L == 3) ? out : nullptr};
                if (REP_OUTX) { pg8::EpiOut E2{QB, (float*)(ws + WS_K), nullptr};
_Pragma("unroll 1")
                    for (int rep = 0; rep < REP_OUTX; ++rep) pg8::gemm_phase<pg8::EpiOut, pg8::StaticOrder, GEMM_ALIGN, GEMM_SP2>(lds, g, S, E2); }
#ifndef NO_OUT
                pg8::gemm_phase<pg8::EpiOut, pg8::StaticOrder, GEMM_ALIGN, GEMM_SP2, OUT_A_AUX>(lds, g, S, E);
#endif
            }
            if (L < 3) SEAM(p0 + 2);
        }
    }
#undef IN
#undef SEAM
}

#ifndef MK_SPLIT
#define MK_SPLIT 0
#endif
extern "C" void kernel_launch(void* const* d_in, const int* in_sizes, int n_in, void* d_out, int out_size, void* d_ws, size_t ws_size, hipStream_t stream) {
    static int grid = 0;
    if (grid == 0) {
        if (n_in != 10 || out_size != MTOK * DM || ws_size < WS_END) { fprintf(stderr, "kernel_launch: unexpected shapes (n_in %d out %d ws %zu)\n", n_in, out_size, ws_size); grid = -1; return; }
        int dev = 0, cus = 0, per_cu = 0;
        hipGetDevice(&dev); hipDeviceGetAttribute(&cus, hipDeviceAttributeMultiprocessorCount, dev);
        hipFuncSetAttribute((const void*)fwd_kernel, hipFuncAttributeMaxDynamicSharedMemorySize, LDS_BYTES);
        if (hipOccupancyMaxActiveBlocksPerMultiprocessor(&per_cu, (const void*)fwd_kernel, 512, LDS_BYTES) != hipSuccess || per_cu < 1) { fprintf(stderr, "kernel_launch: occupancy query says %d\n", per_cu); per_cu = 1; }
        (void)hipGetLastError();
        grid = cus * per_cu;
    }
    if (grid < 0) return;
    if (hipMemsetAsync(d_ws, 0, 16384, stream) != hipSuccess) { fprintf(stderr, "kernel_launch: memset failed\n"); return; }
    Args a{};
    for (int i = 0; i < 10; ++i) a.in[i] = (const float*)d_in[i];
    a.out = (float*)d_out; a.ws = (unsigned char*)d_ws;
#if MK_SPLIT
    for (int p = 0; p < N_PHASES; ++p) { a.ph_lo = p; a.ph_hi = p + 1; hipLaunchKernelGGL(fwd_kernel, dim3(grid), dim3(512), LDS_BYTES, stream, a); }
#else
    a.ph_lo = 0; a.ph_hi = N_PHASES;
    void* kargs[] = {&a};
    hipError_t e = hipLaunchCooperativeKernel((const void*)fwd_kernel, dim3(grid), dim3(512), kargs, LDS_BYTES, stream);
    if (e != hipSuccess) fprintf(stderr, "cooperative launch failed: %s (grid %d)\n", hipGetErrorString(e), grid);
#endif
}
```

```cpp
#include <hip/hip_runtime.h>
#include <hip/hip_cooperative_groups.h>
#include <cstdio>
#include <cstdint>
namespace cg = cooperative_groups;
namespace pg8 {
#define PG8_LAS __attribute__((address_space(3)))
typedef unsigned short bf16_t;
typedef short bf16x8 __attribute__((ext_vector_type(8)));
typedef float f32x4 __attribute__((ext_vector_type(4)));
typedef unsigned u32x4 __attribute__((ext_vector_type(4)));
constexpr int BM = 256, BK = 64, HALF = 128, HTB = HALF * BK * 2  , STAGE_BYTES = 8 * HTB, NXCD = 8, WGM = 8;

__host__ __device__ __forceinline__ int lds_byte(int r, int c) { const int st = (r >> 4) * 2 + (c >> 5), rr = r & 15, cc = c & 31, ob = rr * 64 + cc * 2; return st * 1024 + (ob ^ (((ob >> 9) & 1) << 5)); }
__host__ __device__ __forceinline__ void stage_rc(int b, int& R, int& C) { const int st = b / 1024, sb = b % 1024, swz = sb ^ (((sb >> 9) & 1) << 5); R = (st >> 1) * 16 + swz / 64; C = (st & 1) * 32 + (swz % 64) / 2; }
__host__ __device__ __forceinline__ int perm32(int rho) { const int n = rho >> 4, i = rho & 15; return 8 * (i >> 2) + 4 * n + (i & 3); }

struct Unit { int pm, pn; };
struct Gemm { const bf16_t* A; const bf16_t* Bt; int M, N, K; };

struct StaticOrder {
    int nM, nN, nwg, G, c;
    __host__ __device__ void init(int M, int N, int G_, int c_) { nM = M / BM; nN = N / BM; nwg = nM * nN; G = G_; c = c_; }
    __host__ __device__ bool next(int i, Unit& u) const {
        const long L = (long)i * G + c; if (L >= nwg) return false;
        int wgid = (int)L; { const int q = nwg / NXCD, r = nwg % NXCD, xcd = wgid % NXCD, off = wgid / NXCD; wgid = (xcd < r ? xcd * (q + 1) : r * (q + 1) + (xcd - r) * q) + off; }
        const int nig = WGM * nN, gid = wgid / nig, fm = gid * WGM, gsz = (nM - fm) < WGM ? (nM - fm) : WGM;
        u.pm = fm + ((wgid % nig) % gsz); u.pn = (wgid % nig) / gsz; return true;
    }
    __device__ __forceinline__ void a_ready(const Unit&) const {}
    __device__ __forceinline__ void done(const Unit&) const {}
};
__device__ __forceinline__ unsigned cvt_pk_bf16(float lo, float hi) { unsigned r; asm volatile("v_cvt_pk_bf16_f32 %0, %1, %2" : "=v"(r) : "v"(lo), "v"(hi)); return r; }
typedef float f32x2 __attribute__((ext_vector_type(2)));
template <class Epi, class Sched, bool ALIGN_EPI = false, bool SP2 = false, int A_AUX = 0>
__device__ __forceinline__ void gemm_phase(PG8_LAS unsigned char* lds, const Gemm g, const Sched& S, const Epi& E) {
    int tid_ = threadIdx.x; asm volatile("" : "+v"(tid_));
    const int tid = tid_, wid = __builtin_amdgcn_readfirstlane(tid >> 6), lane = tid & 63, wr = wid >> 2, wc = wid & 3, fr = lane & 15, fq = lane >> 4;
    const int K = g.K, nt = K / BK;
    unsigned voffA[2], voffB[2];
#pragma unroll
    for (int i = 0; i < 2; ++i) { int R, C; stage_rc(tid * 16 + i * 8192, R, C); const int Rb = Epi::PERM ? ((R & ~31) + perm32(R & 31)) : R;
        voffA[i] = (unsigned)(R * K + C) * 2u; voffB[i] = (unsigned)(Rb * K + C) * 2u; }
    const size_t kstep = (size_t)(BK * 2);
    const size_t hstep = (size_t)HALF * K * 2;
    const size_t tstep = 2 * hstep;
    const unsigned ldsw = (unsigned)wid * 1024u;
    const int aoff = lds_byte(wr * 64 + fr, fq * 8), boff = lds_byte(wc * 32 + fr, fq * 8);
#define PG8_SA(b, h) (((b) * 2 + (h)) * HTB)
#define PG8_SB(b, h) ((4 + (b) * 2 + (h)) * HTB)
#define PG8_STAGE(bufoff, gbase, voff) do { _Pragma("unroll") for (int _i = 0; _i < 2; ++_i) \
        __builtin_amdgcn_global_load_lds((const unsigned*)((const char*)(gbase) + (voff)[_i]), (PG8_LAS unsigned*)(lds + (bufoff) + ldsw + _i * 8192), 16, 0, 0); } while (0)
#define PG8_STAGE_A(bufoff, gbase, voff) do { _Pragma("unroll") for (int _i = 0; _i < 2; ++_i) \
        __builtin_amdgcn_global_load_lds((const unsigned*)((const char*)(gbase) + (voff)[_i]), (PG8_LAS unsigned*)(lds + (bufoff) + ldsw + _i * 8192), 16, 0, A_AUX); } while (0)
#define PG8_LDA(dst, b, h) do { _Pragma("unroll") for (int m = 0; m < 4; ++m) _Pragma("unroll") for (int k = 0; k < 2; ++k) dst[m][k] = *(const PG8_LAS bf16x8*)(lds + PG8_SA(b, h) + aoff + m * 2048 + k * 1024); } while (0)
#define PG8_LDB(dst, b, h) do { _Pragma("unroll") for (int n = 0; n < 2; ++n) _Pragma("unroll") for (int k = 0; k < 2; ++k) dst[n][k] = *(const PG8_LAS bf16x8*)(lds + PG8_SB(b, h) + boff + n * 2048 + k * 1024); } while (0)
#define PG8_MMA(ai, bj, At, Bt) do { __builtin_amdgcn_s_setprio(1); _Pragma("unroll") for (int m = 0; m < 4; ++m) _Pragma("unroll") for (int n = 0; n < 2; ++n) _Pragma("unroll") for (int k = 0; k < 2; ++k) \
        acc[ai][bj][m][n] = __builtin_amdgcn_mfma_f32_16x16x32_bf16(Bt[n][k], At[m][k], acc[ai][bj][m][n], 0, 0, 0); __builtin_amdgcn_s_setprio(0); } while (0)
#define PG8_WAIT_V(n) asm volatile("s_waitcnt vmcnt(" #n ")" ::: "memory")
#define PG8_WAIT_L(n) asm volatile("s_waitcnt lgkmcnt(" #n ")" ::: "memory")
#define PG8_BAR __builtin_amdgcn_s_barrier()
#define PG8_SCHED __builtin_amdgcn_sched_barrier(0)
    Unit cur, nxt; int ui = 0;
    if (!S.next(0, cur)) return;
    f32x4 acc[2][2][4][2];
#pragma unroll
    for (int a = 0; a < 2; ++a)
#pragma unroll
        for (int b = 0; b < 2; ++b)
#pragma unroll
            for (int m = 0; m < 4; ++m)
#pragma unroll
                for (int n = 0; n < 2; ++n) acc[a][b][m][n] = (f32x4){0.f, 0.f, 0.f, 0.f};
    bf16x8 At[4][2], B0[2][2], B1[2][2];
    const char* cA = (const char*)g.A + (size_t)cur.pm * tstep; const char* cB = (const char*)g.Bt + (size_t)cur.pn * tstep;
    S.a_ready(cur);
    if constexpr (SP2) {
        PG8_STAGE(PG8_SB(0, 0), cB, voffB); PG8_STAGE(PG8_SB(0, 1), cB + hstep, voffB); PG8_STAGE_A(PG8_SA(0, 0), cA, voffA); PG8_STAGE_A(PG8_SA(0, 1), cA + hstep, voffA);
        if (wr == 1) PG8_BAR;
        PG8_WAIT_V(2); PG8_BAR;
        PG8_STAGE(PG8_SB(1, 0), cB + kstep, voffB); PG8_STAGE_A(PG8_SA(1, 0), cA + kstep, voffA); PG8_STAGE(PG8_SB(1, 1), cB + hstep + kstep, voffB);
        PG8_WAIT_V(6); PG8_BAR;
    } else {
        PG8_STAGE(PG8_SB(0, 0), cB, voffB); PG8_STAGE_A(PG8_SA(0, 0), cA, voffA); PG8_STAGE(PG8_SB(0, 1), cB + hstep, voffB); PG8_STAGE_A(PG8_SA(0, 1), cA + hstep, voffA);
        if (wr == 1) PG8_BAR;
        PG8_WAIT_V(4); PG8_BAR;
        PG8_STAGE(PG8_SB(1, 0), cB + kstep, voffB); PG8_STAGE_A(PG8_SA(1, 0), cA + kstep, voffA); PG8_STAGE(PG8_SB(1, 1), cB + hstep + kstep, voffB);
        PG8_WAIT_V(6); PG8_BAR;
    }
    for (;;) {
        const bool has_next = S.next(ui + 1, nxt);
        const char* nA = has_next ? (const char*)g.A + (size_t)nxt.pm * tstep : cA; const char* nB = has_next ? (const char*)g.Bt + (size_t)nxt.pn * tstep : cB;
        for (int t = 0; t < nt; t += 2) {
            const bool last = (t == nt - 2);
            const char* a1 = cA + (size_t)(t + 1) * kstep;
            const char* a2 = last ? nA : cA + (size_t)(t + 2) * kstep; const char* b2 = last ? nB : cB + (size_t)(t + 2) * kstep;
            const char* a3 = a2 + kstep; const char* b3 = b2 + kstep;
            if (last && has_next) S.a_ready(nxt);
            if constexpr (SP2) {
            PG8_LDB(B0, 0, 0); PG8_LDB(B1, 0, 1); PG8_SCHED; PG8_LDA(At, 0, 0); PG8_STAGE_A(PG8_SA(1, 1), a1 + hstep, voffA);
            PG8_WAIT_V(8); PG8_WAIT_L(0); PG8_BAR; PG8_MMA(0, 0, At, B0); PG8_MMA(0, 1, At, B1); PG8_BAR; PG8_SCHED;
            PG8_LDA(At, 0, 1); PG8_STAGE(PG8_SB(0, 0), b2, voffB); PG8_STAGE(PG8_SB(0, 1), b2 + hstep, voffB); PG8_STAGE_A(PG8_SA(0, 0), a2, voffA);
            PG8_WAIT_V(8); PG8_WAIT_L(0); PG8_BAR; PG8_MMA(1, 0, At, B0); PG8_MMA(1, 1, At, B1); PG8_BAR; PG8_SCHED;
            PG8_LDB(B0, 1, 0); PG8_LDB(B1, 1, 1); PG8_SCHED; PG8_LDA(At, 1, 0); PG8_STAGE_A(PG8_SA(0, 1), a2 + hstep, voffA);
            PG8_WAIT_V(8); PG8_WAIT_L(0); PG8_BAR; PG8_MMA(0, 0, At, B0); PG8_MMA(0, 1, At, B1); PG8_BAR; PG8_SCHED;
            PG8_LDA(At, 1, 1); PG8_STAGE(PG8_SB(1, 0), b3, voffB); PG8_STAGE(PG8_SB(1, 1), b3 + hstep, voffB); PG8_STAGE_A(PG8_SA(1, 0), a3, voffA);
            PG8_WAIT_V(8); PG8_WAIT_L(0); PG8_BAR; PG8_MMA(1, 0, At, B0); PG8_MMA(1, 1, At, B1); PG8_BAR; PG8_SCHED;
            } else {
            PG8_LDB(B0, 0, 0); PG8_SCHED; PG8_LDA(At, 0, 0); PG8_STAGE_A(PG8_SA(1, 1), a1 + hstep, voffA);
            PG8_WAIT_L(8); PG8_BAR; PG8_WAIT_L(0); PG8_MMA(0, 0, At, B0); PG8_BAR; PG8_SCHED;
            PG8_LDB(B1, 0, 1); PG8_STAGE(PG8_SB(0, 0), b2, voffB);
            PG8_BAR; PG8_WAIT_L(0); PG8_MMA(0, 1, At, B1); PG8_BAR;
            PG8_LDA(At, 0, 1); PG8_STAGE_A(PG8_SA(0, 0), a2, voffA);
            PG8_BAR; PG8_WAIT_L(0); PG8_MMA(1, 0, At, B0); PG8_BAR; PG8_SCHED;
            PG8_STAGE(PG8_SB(0, 1), b2 + hstep, voffB);
            PG8_WAIT_V(6); PG8_BAR; PG8_MMA(1, 1, At, B1); PG8_BAR;
            PG8_LDB(B0, 1, 0); PG8_SCHED; PG8_LDA(At, 1, 0); PG8_STAGE_A(PG8_SA(0, 1), a2 + hstep, voffA);
            PG8_WAIT_L(8); PG8_BAR; PG8_WAIT_L(0); PG8_MMA(0, 0, At, B0); PG8_BAR; PG8_SCHED;
            PG8_LDB(B1, 1, 1); PG8_STAGE(PG8_SB(1, 0), b3, voffB);
            PG8_BAR; PG8_WAIT_L(0); PG8_MMA(0, 1, At, B1); PG8_BAR;
            PG8_LDA(At, 1, 1); PG8_STAGE_A(PG8_SA(1, 0), a3, voffA);
            PG8_BAR; PG8_WAIT_L(0); PG8_MMA(1, 0, At, B0); PG8_BAR; PG8_SCHED;
            PG8_STAGE(PG8_SB(1, 1), b3 + hstep, voffB);
            PG8_WAIT_V(6); PG8_BAR; PG8_MMA(1, 1, At, B1); PG8_BAR;
            }
        }
        if constexpr (ALIGN_EPI) { if (wr == 0) PG8_BAR; }
        if constexpr (!Epi::AFTER_DRAIN) { E(acc, cur, wr, wc, fr, fq); S.done(cur); }
        if (!has_next) break;
#pragma unroll
        for (int a = 0; a < 2; ++a)
#pragma unroll
            for (int b = 0; b < 2; ++b)
#pragma unroll
                for (int m = 0; m < 4; ++m)
#pragma unroll
                    for (int n = 0; n < 2; ++n) acc[a][b][m][n] = (f32x4){0.f, 0.f, 0.f, 0.f};
        cur = nxt; cA = nA; cB = nB; ++ui;
        if constexpr (ALIGN_EPI) { if (wr == 1) PG8_BAR; }
    }
    PG8_WAIT_V(0);
    if constexpr (!ALIGN_EPI) { if (wr == 0) PG8_BAR; }
    PG8_BAR;
    if constexpr (Epi::AFTER_DRAIN) { E.fused(acc, cur, wr, wc, fr, fq, lds, wid, lane); S.done(cur); }
#undef PG8_SA
#undef PG8_SB
#undef PG8_STAGE
#undef PG8_STAGE_A
#undef PG8_LDA
#undef PG8_LDB
#undef PG8_MMA
#undef PG8_WAIT_V
#undef PG8_WAIT_L
#undef PG8_BAR
#undef PG8_SCHED
}
}

#ifndef OUT_A_AUX
#define OUT_A_AUX 0
#endif
#ifndef KV_AUX
#define KV_AUX 2
#endif
constexpr int BATCH = 16, SEQ = 2048, DM = 1024, MTOK = BATCH * SEQ;
constexpr int A_IN = 2560, B_IN = 4096;
constexpr float LOG2E = 1.4426950408889634f;
constexpr float QSCALE = 0.125f * LOG2E;
constexpr float NORM_EPS = 1e-6f;

#define LAS __attribute__((address_space(3)))
typedef float v4f __attribute__((ext_vector_type(4)));
typedef unsigned v4u __attribute__((ext_vector_type(4)));
typedef unsigned v2u __attribute__((ext_vector_type(2)));
typedef short s8x __attribute__((ext_vector_type(8)));
typedef float v16f __attribute__((ext_vector_type(16)));
typedef unsigned short bf16_t;

__device__ __forceinline__ float bf_lo(unsigned w) { return __uint_as_float(w << 16); }
__device__ __forceinline__ float bf_hi(unsigned w) { return __uint_as_float(w & 0xffff0000u); }
__device__ __forceinline__ float silu_f(float x) { return x * __builtin_amdgcn_rcpf(1.f + __builtin_amdgcn_exp2f(-x * LOG2E)); }
__device__ __forceinline__ unsigned pk_bf16(float lo, float hi) { return pg8::cvt_pk_bf16(lo, hi); }

namespace pg8 {
typedef unsigned u32x2 __attribute__((ext_vector_type(2)));
__device__ __forceinline__ float row_rstd(const float* ss, int row) {
    const f32x4* p = (const f32x4*)(ss + (size_t)row * 16);
    const f32x4 a = p[0], b = p[1], c = p[2], d = p[3];
    const float s = (((a[0] + a[1]) + (a[2] + a[3])) + ((b[0] + b[1]) + (b[2] + b[3]))) + (((c[0] + c[1]) + (c[2] + c[3])) + ((d[0] + d[1]) + (d[2] + d[3])));
    return __builtin_amdgcn_rsqf(s * (1.f / 1024.f) + NORM_EPS);
}
struct RstdTab { const PG8_LAS float* tab; int pm0, pm1; const float* ss;
    __device__ __forceinline__ float get(int pm, int rl) const { return (pm == pm0) ? tab[rl] : (pm == pm1) ? tab[256 + rl] : row_rstd(ss, pm * 256 + rl); } };
struct EpiAin {
    static constexpr bool PERM = true, AFTER_DRAIN = false;
    bf16_t *Q, *Kb, *Vb, *Gt; RstdTab rt; const float *gq, *gk, *cosT, *sinT;
    __device__ __forceinline__ void operator()(const f32x4 (&acc)[2][2][4][2], const Unit& u, int wr, int wc, int fr, int fq) const {
        const int pn = u.pn;
        if (pn <= 4) {
            const bool isq = pn < 4;
            const float* gp = isq ? gq : gk;
            const float osc = isq ? QSCALE : 1.f;
            f32x4 gv[2][2];
#pragma unroll
            for (int bj = 0; bj < 2; ++bj)
#pragma unroll
                for (int n = 0; n < 2; ++n) gv[bj][n] = *(const f32x4*)(gp + 32 * bj + 8 * fq + 4 * n);
#pragma unroll
            for (int ai = 0; ai < 2; ++ai)
#pragma unroll
                for (int m = 0; m < 4; ++m) {
                    const int row = u.pm * BM + ai * HALF + wr * 64 + m * 16 + fr;
                    const float rstd = rt.get(u.pm, ai * HALF + wr * 64 + m * 16 + fr);
                    f32x4 v[2][2]; float sq = 0.f;
#pragma unroll
                    for (int bj = 0; bj < 2; ++bj)
#pragma unroll
                        for (int n = 0; n < 2; ++n) { v[bj][n] = acc[ai][bj][m][n] * rstd; const f32x4 t2 = v[bj][n] * v[bj][n]; sq += (t2[0] + t2[1]) + (t2[2] + t2[3]); }
                    sq += __shfl_xor(sq, 16); sq += __shfl_xor(sq, 32);
                    const float rn = __builtin_amdgcn_rsqf(sq * (1.f / 64.f) + NORM_EPS);
                    const int t = row & (SEQ - 1);
                    u32x4 w0, w1;
#pragma unroll
                    for (int n = 0; n < 2; ++n) {
                        const f32x4 cs = *(const f32x4*)(cosT + t * 32 + 8 * fq + 4 * n), sn = *(const f32x4*)(sinT + t * 32 + 8 * fq + 4 * n);
                        const f32x4 y1 = v[0][n] * rn * gv[0][n], y2 = v[1][n] * rn * gv[1][n];
                        const f32x4 o1 = (y1 * cs - y2 * sn) * osc, o2 = (y2 * cs + y1 * sn) * osc;
                        w0[2 * n] = cvt_pk_bf16(o1[0], o1[1]); w0[2 * n + 1] = cvt_pk_bf16(o1[2], o1[3]);
                        w1[2 * n] = cvt_pk_bf16(o2[0], o2[1]); w1[2 * n + 1] = cvt_pk_bf16(o2[2], o2[3]);
                    }
                    if (isq) { bf16_t* p = Q + ((size_t)(row >> 5) * 16 + (4 * pn + wc)) * 2048 + (row & 31) * 8;
                        *(u32x4*)(p + fq * 256) = w0; *(u32x4*)(p + (4 + fq) * 256) = w1; }
                    else {
                        const int b = row >> 11; bf16_t* p = Kb + (size_t)((b * 4 + wc) * 32 + (t >> 6)) * 4096 + (t & 63) * 8;
                        *(u32x4*)(p + fq * 512) = w0; *(u32x4*)(p + (4 + fq) * 512) = w1;
                    }
                }
        } else if (pn == 5) {
#pragma unroll
            for (int ai = 0; ai < 2; ++ai)
#pragma unroll
                for (int m = 0; m < 4; ++m) {
                    const int row = u.pm * BM + ai * HALF + wr * 64 + m * 16 + fr;
                    const float rstd = rt.get(u.pm, ai * HALF + wr * 64 + m * 16 + fr);
                    const int t = row & (SEQ - 1), b = row >> 11;
                    bf16_t* p = Vb + (size_t)((b * 4 + wc) * 32 + (t >> 6)) * 4096 + ((t & 63) >> 3) * 256 + (t & 7) * 32 + 8 * fq;
#pragma unroll
                    for (int bj = 0; bj < 2; ++bj) { const f32x4 a = acc[ai][bj][m][0] * rstd, c = acc[ai][bj][m][1] * rstd;
                        u32x4 w; w.x = cvt_pk_bf16(a[0], a[1]); w.y = cvt_pk_bf16(a[2], a[3]); w.z = cvt_pk_bf16(c[0], c[1]); w.w = cvt_pk_bf16(c[2], c[3]);
                        *(u32x4*)(p + bj * 2048) = w; }
                }
        } else {
#pragma unroll
            for (int ai = 0; ai < 2; ++ai)
#pragma unroll
                for (int m = 0; m < 4; ++m) {
                    const int row = u.pm * BM + ai * HALF + wr * 64 + m * 16 + fr;
                    const float rstd = rt.get(u.pm, ai * HALF + wr * 64 + m * 16 + fr);
                    bf16_t* p = Gt + ((size_t)(row >> 5) * 16 + (4 * (pn - 6) + wc)) * 2048 + (row & 31) * 8;
#pragma unroll
                    for (int bj = 0; bj < 2; ++bj) { const f32x4 a = acc[ai][bj][m][0] * rstd, c = acc[ai][bj][m][1] * rstd;
                        u32x4 w; w.x = cvt_pk_bf16(a[0], a[1]); w.y = cvt_pk_bf16(a[2], a[3]); w.z = cvt_pk_bf16(c[0], c[1]); w.w = cvt_pk_bf16(c[2], c[3]);
                        *(u32x4*)(p + (bj * 4 + fq) * 256) = w; }
                }
        }
    }
};
struct EpiBin {
    static constexpr bool PERM = true, AFTER_DRAIN = false;
    bf16_t *Y, *ZH, *CH; RstdTab rt; const float *cw; float* YP;
    __device__ __forceinline__ void operator()(const f32x4 (&acc)[2][2][4][2], const Unit& u, int wr, int wc, int fr, int fq) const {
        const int ch = u.pn * 64 + wc * 16 + fq * 4, lane = fq * 16 + fr;
        const f32x4 w0 = *(const f32x4*)(cw + ch), w1 = *(const f32x4*)(cw + 1024 + ch), w2 = *(const f32x4*)(cw + 2048 + ch);
        const int srcp = (fr == 0) ? lane + 15 : lane - 1, srcn = (fr == 15) ? lane - 15 : lane + 1;
#pragma unroll
        for (int ai = 0; ai < 2; ++ai) {
            f32x4 z[4], s[4];
#pragma unroll
            for (int m = 0; m < 4; ++m) {
                const int row = u.pm * BM + ai * HALF + wr * 64 + m * 16 + fr;
                const float rstd = rt.get(u.pm, ai * HALF + wr * 64 + m * 16 + fr);
                const f32x4 bg = acc[ai][0][m][0] * rstd, cgv = acc[ai][0][m][1] * rstd, uv = acc[ai][1][m][0] * rstd, gt = acc[ai][1][m][1] * rstd;
                z[m] = cgv * uv;
#pragma unroll
                for (int i = 0; i < 4; ++i) s[m][i] = bg[i] * silu_f(gt[i]);
            }
            const int g2 = ((u.pm * BM + ai * HALF + wr * 64) >> 6) * 2;
#pragma unroll
            for (int m = 0; m < 4; ++m) {
                const int row = u.pm * BM + ai * HALF + wr * 64 + m * 16 + fr;
                f32x4 zp, zn;
#pragma unroll
                for (int i = 0; i < 4; ++i) {
                    const float sp = (m > 0 && fr == 15) ? z[m > 0 ? m - 1 : 0][i] : z[m][i];
                    const float a = __shfl(sp, srcp);
                    zp[i] = (m == 0 && fr == 0) ? 0.f : a;
                    const float sn = (m < 3 && fr == 0) ? z[m < 3 ? m + 1 : 3][i] : z[m][i];
                    const float b = __shfl(sn, srcn);
                    zn[i] = (m == 3 && fr == 15) ? 0.f : b;
                }
                const f32x4 y = s[m] * (w0 * zp + w1 * z[m] + w2 * zn);
                u32x2 wy; wy.x = cvt_pk_bf16(y[0], y[1]); wy.y = cvt_pk_bf16(y[2], y[3]);
                *(u32x2*)(Y + (size_t)row * 1024 + ch) = wy;
                if (m == 0 && fr == 0) { const f32x4 c = s[0] * w0; u32x2 a, b; a.x = cvt_pk_bf16(z[0][0], z[0][1]); a.y = cvt_pk_bf16(z[0][2], z[0][3]); b.x = cvt_pk_bf16(c[0], c[1]); b.y = cvt_pk_bf16(c[2], c[3]);
                    *(u32x2*)(ZH + (size_t)g2 * 1024 + ch) = a; *(u32x2*)(CH + (size_t)g2 * 1024 + ch) = b; *(f32x4*)(YP + (size_t)g2 * 1024 + ch) = y; }
                if (m == 3 && fr == 15) { const f32x4 c = s[3] * w2; u32x2 a, b; a.x = cvt_pk_bf16(z[3][0], z[3][1]); a.y = cvt_pk_bf16(z[3][2], z[3][3]); b.x = cvt_pk_bf16(c[0], c[1]); b.y = cvt_pk_bf16(c[2], c[3]);
                    *(u32x2*)(ZH + (size_t)(g2 + 1) * 1024 + ch) = a; *(u32x2*)(CH + (size_t)(g2 + 1) * 1024 + ch) = b; *(f32x4*)(YP + (size_t)(g2 + 1) * 1024 + ch) = y; }
            }
        }
    }
};
struct EpiOut {
    static constexpr bool PERM = true, AFTER_DRAIN = false;
    bf16_t* xb; float* ss; float* fout;
    __device__ __forceinline__ void operator()(const f32x4 (&acc)[2][2][4][2], const Unit& u, int wr, int wc, int fr, int fq) const {
#pragma unroll
        for (int ai = 0; ai < 2; ++ai)
#pragma unroll
            for (int m = 0; m < 4; ++m) {
                const int row = u.pm * BM + ai * HALF + wr * 64 + m * 16 + fr;
                const size_t off = (size_t)row * 1024 + u.pn * BM + wc * 32 + 8 * fq;
                float sq = 0.f;
                u32x4 xw[2];
#pragma unroll
                for (int bj = 0; bj < 2; ++bj) xw[bj] = *(const u32x4*)(xb + off + bj * HALF);
#pragma unroll
                for (int bj = 0; bj < 2; ++bj) {
                    const f32x4 x0 = {bf_lo(xw[bj].x), bf_hi(xw[bj].x), bf_lo(xw[bj].y), bf_hi(xw[bj].y)}, x1 = {bf_lo(xw[bj].z), bf_hi(xw[bj].z), bf_lo(xw[bj].w), bf_hi(xw[bj].w)};
                    const f32x4 o0 = x0 + acc[ai][bj][m][0], o1 = x1 + acc[ai][bj][m][1];
                    if (fout) { __builtin_nontemporal_store(o0, (f32x4*)(fout + off + bj * HALF)); __builtin_nontemporal_store(o1, (f32x4*)(fout + off + bj * HALF + 4)); }
                    else {
                        u32x4 w; w.x = cvt_pk_bf16(o0[0], o0[1]); w.y = cvt_pk_bf16(o0[2], o0[3]); w.z = cvt_pk_bf16(o1[0], o1[1]); w.w = cvt_pk_bf16(o1[2], o1[3]);
                        *(u32x4*)(xb + off + bj * HALF) = w;
                        const f32x4 q0 = o0 * o0, q1 = o1 * o1; sq += ((q0[0] + q0[1]) + (q0[2] + q0[3])) + ((q1[0] + q1[1]) + (q1[2] + q1[3]));
                    }
                }
                if (!fout) { sq += __shfl_xor(sq, 16); sq += __shfl_xor(sq, 32); if (fq == 0) ss[(size_t)row * 16 + u.pn * 4 + wc] = sq; }
            }
    }
};
}

typedef LAS const char* lds_cptr;
typedef short v4i16_t __attribute__((ext_vector_type(4)));
__device__ __forceinline__ v4i16_t vtr(lds_cptr p) { return __builtin_amdgcn_ds_read_tr16_b64_v4i16((LAS v4i16_t*)p); }
#define MFMA32(a, b, c) __builtin_amdgcn_mfma_f32_32x32x16_bf16((a), (b), (c), 0, 0, 0)

__device__ __forceinline__ void attn_dma_block(LAS unsigned char* lds, const bf16_t* __restrict__ Kg, const bf16_t* __restrict__ Vg, int bkh, int blk, int wid, int lane) {
    const int slot = blk & 3;
#pragma unroll
    for (int t = 0; t < 2; ++t) {
        const size_t goff = (size_t)(bkh * 32 + 2 * blk + t) * 4096 + wid * 512 + lane * 8;
        LAS unsigned char* kd = lds + slot * 16384 + t * 8192 + wid * 1024;
        __builtin_amdgcn_global_load_lds((const unsigned*)(Kg + goff), (LAS unsigned*)kd, 16, 0, KV_AUX);
        __builtin_amdgcn_global_load_lds((const unsigned*)(Vg + goff), (LAS unsigned*)(kd + 65536), 16, 0, KV_AUX);
    }
}
__device__ __forceinline__ void attn_phase(LAS unsigned char* lds, const bf16_t* __restrict__ Q, const bf16_t* __restrict__ Kg, const bf16_t* __restrict__ Vg,
                                           const bf16_t* __restrict__ Gt, bf16_t* __restrict__ OG, const float* __restrict__ sink, float shift2, int c0, int G) {
    int tid_ = threadIdx.x; asm volatile("" : "+v"(tid_));
    const int tid = tid_, lane = tid & 63, wid = __builtin_amdgcn_readfirstlane(tid >> 6), r = lane & 31, h = lane >> 5;
    const int par = wid & 1, gh = wid >> 1, qoff = par * 64;
    const int voff = (4 * h + ((lane & 15) >> 2)) * 64 + ((lane >> 4) & 1) * 32 + (lane & 3) * 8;
    v16f negs;
#pragma unroll
    for (int i = 0; i < 16; ++i) negs[i] = -shift2;
    asm volatile("" : "+v"(negs));
    if (wid >= 4) __builtin_amdgcn_s_setprio(1);
    for (int su = c0; su < BATCH * 4 * 4; su += G) {
        const int bkh = su >> 2, b = bkh >> 2, kh = bkh & 3, n0 = (su & 3) * 4;
        const int head = kh * 4 + gh;
        if (n0 > 0) attn_dma_block(lds, Kg, Vg, bkh, n0 - 1, wid, lane);
        attn_dma_block(lds, Kg, Vg, bkh, n0, wid, lane);
        attn_dma_block(lds, Kg, Vg, bkh, n0 + 1, wid, lane);
        s8x qf[2][4];
#pragma unroll
        for (int qs = 0; qs < 2; ++qs)
#pragma unroll
            for (int ds = 0; ds < 4; ++ds) qf[qs][ds] = __builtin_nontemporal_load((const s8x*)(Q + ((size_t)((b * SEQ + n0 * 128 + qoff + 32 * qs) >> 5) * 16 + head) * 2048 + ((2 * ds + h) * 32 + r) * 8));
        asm volatile("s_waitcnt vmcnt(0)" ::: "memory");
        __syncthreads();
#pragma unroll 1
        for (int n = n0; n < n0 + 4; ++n) {
            const int kt0 = (n == 0) ? 2 : 0, kt1 = (n == 15) ? 4 : 6;
            const int row0 = b * SEQ + n * 128 + qoff;
            if (n < n0 + 3 && n + 2 <= 15) attn_dma_block(lds, Kg, Vg, bkh, n + 2, wid, lane);
            v16f o[2][2];
#pragma unroll
            for (int a = 0; a < 2; ++a)
#pragma unroll
                for (int c = 0; c < 2; ++c)
#pragma unroll
                    for (int i = 0; i < 16; ++i) o[a][c][i] = 0.f;
            float l0 = 0.f, l1 = 0.f;
            const int wlo = kt0 > par ? kt0 : par, whi = kt1 < 5 + par ? kt1 : 5 + par;
            v2u gwv[2][2][4];
#ifndef REP_ATTLOOP
#define REP_ATTLOOP 1
#endif
_Pragma("unroll 1")
            for (int rep_ = 0; rep_ < REP_ATTLOOP; ++rep_) {
            const int s0 = 2 * wlo, s1 = 2 * whi;
#define ATT_KADDR(stp) ((lds_cptr)lds + ((n - 1 + ((stp) >> 2)) & 3) * 16384 + (((stp) >> 1) & 1) * 8192 + h * 1024 + (32 * ((stp) & 1) + r) * 16)
#define ATT_VADDR(stp) ((lds_cptr)lds + 65536 + ((n - 1 + ((stp) >> 2)) & 3) * 16384 + (((stp) >> 1) & 1) * 8192 + ((stp) & 1) * 2048 + voff)
#define ATT_MASK(stp, A0, A1) do { const int kt_ = (stp) >> 1; if ((kt_ == par) || (kt_ == 4 + par)) { asm volatile("" ::: "memory"); \
                const int cb = 32 * (stp) + 4 * h, iq0 = qoff + r, iq1 = iq0 + 32; \
                _Pragma("unroll") for (int i = 0; i < 16; ++i) { const int c = cb + (i & 3) + 8 * (i >> 2); \
                    if (!(c >= iq0 && c <= iq0 + 256)) A0[i] = -INFINITY; if (!(c >= iq1 && c <= iq1 + 256)) A1[i] = -INFINITY; } } } while (0)
#define ATT_EXP_PACK(A0, A1, PK) do { _Pragma("unroll") for (int i = 0; i < 16; ++i) { A0[i] = __builtin_amdgcn_exp2f(A0[i]); A1[i] = __builtin_amdgcn_exp2f(A1[i]); l0 += A0[i]; l1 += A1[i]; } \
                _Pragma("unroll") for (int s = 0; s < 2; ++s) _Pragma("unroll") for (int j = 0; j < 4; ++j) { PK[s][0][j] = pk_bf16(A0[8 * s + 2 * j], A0[8 * s + 2 * j + 1]); PK[s][1][j] = pk_bf16(A1[8 * s + 2 * j], A1[8 * s + 2 * j + 1]); } } while (0)
            s8x kfr[4]; v4u pcur[2][2];
            {   const lds_cptr kp = ATT_KADDR(s0);
#pragma unroll
                for (int ds = 0; ds < 4; ++ds) kfr[ds] = *(const LAS s8x*)(kp + ds * 2048);
                v16f st0 = negs, st1 = negs;
#pragma unroll
                for (int ds = 0; ds < 4; ++ds) { st0 = MFMA32(kfr[ds], qf[0][ds], st0); st1 = MFMA32(kfr[ds], qf[1][ds], st1); }
                const lds_cptr kp2 = ATT_KADDR(s0 + 1 < s1 ? s0 + 1 : s0);
#pragma unroll
                for (int ds = 0; ds < 4; ++ds) kfr[ds] = *(const LAS s8x*)(kp2 + ds * 2048);
                ATT_MASK(s0, st0, st1);
                ATT_EXP_PACK(st0, st1, pcur);
            }
#pragma unroll 1
            for (int step = s0; step < s1 - 1; ++step) {
                s8x vf[2][2];
                {   const lds_cptr vp = ATT_VADDR(step);
#pragma unroll
                    for (int s = 0; s < 2; ++s)
#pragma unroll
                        for (int dblk = 0; dblk < 2; ++dblk) { const v4i16_t lo = vtr(vp + dblk * 4096 + s * 1024), hi = vtr(vp + dblk * 4096 + s * 1024 + 512); vf[s][dblk] = __builtin_shufflevector(lo, hi, 0, 1, 2, 3, 4, 5, 6, 7); } }
                v16f st0 = negs, st1 = negs;
#pragma unroll
                for (int ds = 0; ds < 4; ++ds) { st0 = MFMA32(kfr[ds], qf[0][ds], st0); st1 = MFMA32(kfr[ds], qf[1][ds], st1); }
                {   const lds_cptr kp = ATT_KADDR(step + 2 < s1 ? step + 2 : step + 1);
#pragma unroll
                    for (int ds = 0; ds < 4; ++ds) kfr[ds] = *(const LAS s8x*)(kp + ds * 2048); }
                ATT_MASK(step + 1, st0, st1);
                __builtin_amdgcn_sched_barrier(0);
                v4u pnext[2][2];
#pragma unroll
                for (int s = 0; s < 2; ++s)
#pragma unroll
                    for (int dblk = 0; dblk < 2; ++dblk) { o[dblk][0] = MFMA32(vf[s][dblk], __builtin_bit_cast(s8x, pcur[s][0]), o[dblk][0]); o[dblk][1] = MFMA32(vf[s][dblk], __builtin_bit_cast(s8x, pcur[s][1]), o[dblk][1]); }
                ATT_EXP_PACK(st0, st1, pnext);
#pragma unroll
                for (int k = 0; k < 8; ++k) { __builtin_amdgcn_sched_group_barrier(0x008, 1, 0); __builtin_amdgcn_sched_group_barrier(0x002, 11, 0); }
                __builtin_amdgcn_sched_barrier(0);
#pragma unroll
                for (int s = 0; s < 2; ++s) { pcur[s][0] = pnext[s][0]; pcur[s][1] = pnext[s][1]; }
            }
            if (n < n0 + 3) {
#pragma unroll
                for (int qs = 0; qs < 2; ++qs)
#pragma unroll
                    for (int ds = 0; ds < 4; ++ds) qf[qs][ds] = __builtin_nontemporal_load((const s8x*)(Q + ((size_t)((row0 + 128 + 32 * qs) >> 5) * 16 + head) * 2048 + ((2 * ds + h) * 32 + r) * 8));
            }
#pragma unroll
            for (int qs = 0; qs < 2; ++qs)
#pragma unroll
                for (int dblk = 0; dblk < 2; ++dblk)
#pragma unroll
                    for (int gi = 0; gi < 4; ++gi) gwv[qs][dblk][gi] = __builtin_nontemporal_load((const v2u*)(Gt + ((size_t)((row0 + 32 * qs) >> 5) * 16 + head) * 2048 + r * 8 + h * 4 + (dblk * 4 + gi) * 256));
            {
                const lds_cptr vp = ATT_VADDR(s1 - 1);
#pragma unroll
                for (int s = 0; s < 2; ++s)
#pragma unroll
                    for (int dblk = 0; dblk < 2; ++dblk) { const v4i16_t lo = vtr(vp + dblk * 4096 + s * 1024), hi = vtr(vp + dblk * 4096 + s * 1024 + 512); const s8x vfr = __builtin_shufflevector(lo, hi, 0, 1, 2, 3, 4, 5, 6, 7);
                        o[dblk][0] = MFMA32(vfr, __builtin_bit_cast(s8x, pcur[s][0]), o[dblk][0]); o[dblk][1] = MFMA32(vfr, __builtin_bit_cast(s8x, pcur[s][1]), o[dblk][1]); }
            }
            }
#undef ATT_KADDR
#undef ATT_VADDR
#undef ATT_MASK
#undef ATT_EXP_PACK
            asm volatile("s_waitcnt vmcnt(0)" ::: "memory");
            __syncthreads();
            l0 += __shfl_xor(l0, 32); l1 += __shfl_xor(l1, 32);
            const float sk = (float)REP_ATTLOOP * __builtin_amdgcn_exp2f(sink[head] * LOG2E - shift2);
            const float inv0 = 1.f / (l0 + sk), inv1 = 1.f / (l1 + sk);
#pragma unroll
            for (int qs = 0; qs < 2; ++qs) {
                bf16_t* op = OG + (size_t)(row0 + 32 * qs + r) * 1024 + head * 64 + h * 32;
                const float inv = qs ? inv1 : inv0;
#pragma unroll
                for (int dblk = 0; dblk < 2; ++dblk) {
                    unsigned w[8];
#pragma unroll
                    for (int gi = 0; gi < 4; ++gi) {
                        const float a0 = o[dblk][qs][4 * gi] * inv * silu_f(bf_lo(gwv[qs][dblk][gi].x)), a1 = o[dblk][qs][4 * gi + 1] * inv * silu_f(bf_hi(gwv[qs][dblk][gi].x));
                        const float a2 = o[dblk][qs][4 * gi + 2] * inv * silu_f(bf_lo(gwv[qs][dblk][gi].y)), a3 = o[dblk][qs][4 * gi + 3] * inv * silu_f(bf_hi(gwv[qs][dblk][gi].y));
                        w[2 * gi] = pk_bf16(a0, a1); w[2 * gi + 1] = pk_bf16(a2, a3);
                    }
                    *(v4u*)(op + dblk * 16) = (v4u){w[0], w[1], w[2], w[3]}; *(v4u*)(op + dblk * 16 + 8) = (v4u){w[4], w[5], w[6], w[7]};
                }
            }
        }
    }
    __builtin_amdgcn_s_setprio(0);
}

__device__ __forceinline__ void unpack8(const v4u w, float (&f)[8]) { f[0] = bf_lo(w.x); f[1] = bf_hi(w.x); f[2] = bf_lo(w.y); f[3] = bf_hi(w.y); f[4] = bf_lo(w.z); f[5] = bf_hi(w.z); f[6] = bf_lo(w.w); f[7] = bf_hi(w.w); }
template <class Sched> __device__ __forceinline__ void conv_fix_tiles(const Sched& S, bf16_t* __restrict__ Y, const float* __restrict__ YP, const bf16_t* __restrict__ ZH, const bf16_t* __restrict__ CH) {
    int tid_ = threadIdx.x; asm volatile("" : "+v"(tid_));
    const int tid = tid_;
    pg8::Unit u;
    for (int i = 0; S.next(i, u); ++i) {
#pragma unroll
        for (int w = tid; w < 1024; w += 512) {
            const int rowi = w >> 7, g = 4 * u.pm + (rowi >> 1), side = rowi & 1, ch = (w & 127) * 8;
            const int t = 64 * g + (side ? 63 : 0);
            const bool has = side ? (((t + 1) & (SEQ - 1)) != 0) : ((t & (SEQ - 1)) != 0);
            const v4f y0 = *(const v4f*)(YP + (size_t)(2 * g + side) * 1024 + ch), y1 = *(const v4f*)(YP + (size_t)(2 * g + side) * 1024 + ch + 4);
            float y[8] = {y0[0], y0[1], y0[2], y0[3], y1[0], y1[1], y1[2], y1[3]};
            if (has) {
                const v4u cwv = *(const v4u*)(CH + (size_t)(2 * g + side) * 1024 + ch);
                const v4u zw = *(const v4u*)(ZH + (size_t)(side ? 2 * (g + 1) : 2 * (g - 1) + 1) * 1024 + ch);
                float c[8], z[8]; unpack8(cwv, c); unpack8(zw, z);
#pragma unroll
                for (int k = 0; k < 8; ++k) y[k] += c[k] * z[k];
            }
            v4u o; o.x = pk_bf16(y[0], y[1]); o.y = pk_bf16(y[2], y[3]); o.z = pk_bf16(y[4], y[5]); o.w = pk_bf16(y[6], y[7]);
            *(v4u*)(Y + (size_t)t * 1024 + ch) = o;
        }
    }
    asm volatile("s_waitcnt vmcnt(0)" ::: "memory");
    __syncthreads();
}

__device__ __forceinline__ int dst_row(int kind, int j) {
    if (kind == 0) return j;
    if (kind == 1) { const int pn = j >> 8, jj = j & 255, head = jj >> 6, d = jj & 63; return pn * 256 + (d >> 5) * 128 + head * 32 + (d & 31); }
    const int knd = j >> 10, chan = j & 1023, pn = chan >> 6, cl = chan & 63, wc = cl >> 4, fq = (cl >> 2) & 3, i = cl & 3;
    return pn * 256 + (knd >> 1) * 128 + wc * 32 + fq * 8 + (knd & 1) * 4 + i;
}
__device__ __forceinline__ int kperm_og(int kp) { const int p = kp & 63, hh = p >> 5, dblk = (p >> 4) & 1, i = p & 15; return (kp & ~63) | (32 * dblk + 8 * (i >> 2) + 4 * hh + (i & 3)); }
__device__ __forceinline__ void transpose_block(const float* __restrict__ W, int K, int N, bf16_t* __restrict__ WT, int kind, const float* __restrict__ g, LAS float* T, int item, int tid, bool kp) {
    const int nblk = N / 256, kb = item / nblk, nb = item % nblk, k0 = 64 * kb, n0 = 256 * nb;
    constexpr int P = 257;
#pragma unroll
    for (int i = 0; i < 8; ++i) {
        const int q = tid + 512 * i, kk = q >> 6, c4 = q & 63;
        const int ks = kp ? kperm_og(k0 + kk) : (k0 + kk);
        v4f w = __builtin_nontemporal_load((const v4f*)(W + (size_t)ks * N + n0 + 4 * c4));
        if (g) w = w * g[ks];
        LAS float* t = T + kk * P + 4 * c4;
        t[0] = w[0]; t[1] = w[1]; t[2] = w[2]; t[3] = w[3];
    }
    __syncthreads();
#pragma unroll
    for (int j = 0; j < 4; ++j) {
        const int o = tid + 512 * j, c = o & 7, n = o >> 3;
        const LAS float* t = T + (8 * c) * P + n;
        v4u ov; ov.x = pk_bf16(t[0], t[P]); ov.y = pk_bf16(t[2 * P], t[3 * P]); ov.z = pk_bf16(t[4 * P], t[5 * P]); ov.w = pk_bf16(t[6 * P], t[7 * P]);
        *(v4u*)(WT + (size_t)dst_row(kind, n0 + n) * K + k0 + 8 * c) = ov;
    }
    __syncthreads();
}

#define XB_TMO      128
#define XB_XCNT(j)  (256  + 64 * (j))
#define XB_XSUB(j)  (1280 + 64 * (j))
#define XB_XGEN(j)  (2304 + 64 * (j))
#define XB_TOP      3328
#define XB_TOPGEN   3392
#define XCD_BAR_WORDS 3456
#define XB_SPIN_CAP (1u << 18)

__device__ __forceinline__ unsigned xb_ld(unsigned* p)              { return __hip_atomic_load(p, __ATOMIC_RELAXED, __HIP_MEMORY_SCOPE_AGENT); }
__device__ __forceinline__ unsigned xb_add(unsigned* p, unsigned v) { return __hip_atomic_fetch_add(p, v, __ATOMIC_RELAXED, __HIP_MEMORY_SCOPE_AGENT); }
__device__ __forceinline__ unsigned xb_xcc_id() { return (unsigned)__builtin_amdgcn_s_getreg((3 << 11) | 20) & 0xFu; }
#define XB_SPIN(cond, bar) do { unsigned _sp = 0; while (cond) { __builtin_amdgcn_s_sleep(1); \
    if ((++_sp & 255u) == 0u) { if (xb_ld(&(bar)[XB_TMO])) break; if (_sp > XB_SPIN_CAP) { atomicAdd(&(bar)[XB_TMO], 1u); break; } } } } while (0)

struct XcdBarrier {
    unsigned* bar; unsigned x;
    volatile LAS unsigned* st;
};

__device__ __forceinline__ XcdBarrier xcd_barrier_post(unsigned* bar, volatile LAS unsigned* st) {
    XcdBarrier b; b.bar = bar; b.x = xb_xcc_id(); b.st = st;
    if (threadIdx.x == 0) (void)xb_add(&bar[XB_XCNT(b.x)], 1u);
    return b;
}
__device__ __forceinline__ void xcd_barrier_complete(unsigned* bar, unsigned x, unsigned& nloc, unsigned& nx) {
    const unsigned G = gridDim.x * gridDim.y * gridDim.z;
    unsigned sum, cnt, mine, sp = 0u;
    for (;;) {
        sum = 0u; cnt = 0u; mine = 0u;
#pragma unroll
        for (unsigned j = 0; j < 16; ++j) { const unsigned c = xb_ld(&bar[XB_XCNT(j)]); sum += c; cnt += (c > 0u) ? 1u : 0u; mine = (j == x) ? c : mine; }
        if (sum == G) break;
        __builtin_amdgcn_s_sleep(1);
        if ((++sp & 255u) == 0u) { if (xb_ld(&bar[XB_TMO])) break; if (sp > XB_SPIN_CAP) { atomicAdd(&bar[XB_TMO], 1u); break; } }
    }
    nloc = mine > 0u ? mine : 1u; nx = cnt > 0u ? cnt : 1u;
}

__device__ __forceinline__ void xcd_barrier(const XcdBarrier& b) {
    asm volatile("s_waitcnt vmcnt(0)" ::: "memory");
    __syncthreads();
    if (threadIdx.x == 0) {
        unsigned* bar = b.bar;
        __builtin_amdgcn_s_waitcnt(0);
        unsigned nloc = b.st[0], nx = b.st[1];
        if (nloc == 0u) { xcd_barrier_complete(bar, b.x, nloc, nx); b.st[0] = nloc; b.st[1] = nx; }
        const unsigned old = xb_add(&bar[XB_XSUB(b.x)], 1u);
        const unsigned gen = old / nloc;
        if (old + 1u == (gen + 1u) * nloc) {
            __builtin_amdgcn_fence(__ATOMIC_RELEASE, "agent");
            asm volatile("s_waitcnt vmcnt(0)" ::: "memory");
            const unsigned og = xb_add(&bar[XB_TOP], 1u);
            const unsigned tg = og / nx;
            if (og + 1u == (tg + 1u) * nx) xb_add(&bar[XB_TOPGEN], 1u);
            else XB_SPIN(xb_ld(&bar[XB_TOPGEN]) == tg, bar);
            __builtin_amdgcn_fence(__ATOMIC_ACQUIRE, "agent");
            xb_add(&bar[XB_XGEN(b.x)], 1u);
            asm volatile("s_waitcnt vmcnt(0)" ::: "memory");
        } else {
            XB_SPIN(xb_ld(&bar[XB_XGEN(b.x)]) == gen, bar);
            __builtin_amdgcn_fence(__ATOMIC_ACQUIRE, "agent");
            asm volatile("s_waitcnt vmcnt(0)" ::: "memory");
        }
    }
    __syncthreads();
}

constexpr size_t MiB = 1u << 20;
constexpr size_t WS_COS = 1 * MiB, WS_SIN = WS_COS + 256 * 1024;
constexpr size_t WS_SS = 2 * MiB;
constexpr size_t WS_WAIN = 4 * MiB, WS_WAOUT = 14 * MiB, WS_WBIN = 18 * MiB, WS_WBOUT = 34 * MiB;
constexpr size_t WS_XB = 40 * MiB;
constexpr size_t WS_Q = 104 * MiB;
constexpr size_t WS_G = 168 * MiB;
constexpr size_t WS_K = 232 * MiB, WS_V = 248 * MiB;
constexpr size_t WS_OG = 264 * MiB;
constexpr size_t WS_END = 328 * MiB;
constexpr int LDS_BYTES = 135168;

template <class Sched> __device__ __forceinline__ pg8::RstdTab rstd_table_fill(const Sched& S, LAS float* tab, const float* ss) {
    int tid_ = threadIdx.x; asm volatile("" : "+v"(tid_));
    const int tid = tid_;
    pg8::Unit u; int pm0 = -1, pm1 = -1;
    for (int i = 0; S.next(i, u); ++i) { if (pm0 < 0) pm0 = u.pm; else if (u.pm != pm0 && pm1 < 0) pm1 = u.pm; }
    const int pm = (tid < 256) ? pm0 : pm1;
    if (pm >= 0) tab[tid] = pg8::row_rstd(ss, pm * 256 + (tid & 255));
    __syncthreads();
    return pg8::RstdTab{tab, pm0, pm1, ss};
}
#ifndef REP_P0
#define REP_P0 1
#endif
#ifndef REP_OUTX
#define REP_OUTX 0
#endif
#ifndef REP_AIN
#define REP_AIN 1
#endif
#ifndef REP_ATTN
#define REP_ATTN 1
#endif
#ifndef REP_AOUT0
#define REP_AOUT0 1
#endif
#ifndef REP_BIN
#define REP_BIN 1
#endif
#ifndef REP_CONV
#define REP_CONV 1
#endif
#ifndef GEMM_ALIGN
#define GEMM_ALIGN true
#endif
#ifndef GEMM_SP2
#define GEMM_SP2 true
#endif
struct Args { const float* in[10]; float* out; unsigned char* ws; int ph_lo, ph_hi; };
constexpr int N_PHASES = 13;

__global__ void __launch_bounds__(512, 2) fwd_kernel(Args args) {
    extern __shared__ __attribute__((aligned(16))) unsigned char lds_raw[];
    LAS unsigned char* lds = (LAS unsigned char*)lds_raw;
    cg::grid_group grid = cg::this_grid();
    const int tid = threadIdx.x, lane = tid & 63, wave = __builtin_amdgcn_readfirstlane(tid >> 6);
    const int G = gridDim.x, bx = blockIdx.x;
    unsigned char* ws = args.ws;
    const float* x_in = args.in[0]; const float* norm_g = args.in[1]; const float* a_w_in = args.in[2]; const float* a_qn = args.in[3]; const float* a_kn = args.in[4];
    const float* a_sink = args.in[5]; const float* a_w_out = args.in[6]; const float* b_w_in = args.in[7]; const float* b_conv = args.in[8]; const float* b_w_out = args.in[9];
    float* out = args.out;
    float* cosT = (float*)(ws + WS_COS); float* sinT = (float*)(ws + WS_SIN); float* ss = (float*)(ws + WS_SS);
    bf16_t* XB = (bf16_t*)(ws + WS_XB); bf16_t* QB = (bf16_t*)(ws + WS_Q); bf16_t* GB = (bf16_t*)(ws + WS_G); bf16_t* KB = (bf16_t*)(ws + WS_K); bf16_t* VB = (bf16_t*)(ws + WS_V); bf16_t* OGB = (bf16_t*)(ws + WS_OG);
    const int lo = args.ph_lo, hi = args.ph_hi;
#define IN(k) (lo <= (k) && (k) < hi)
#ifdef SEAM_X3
#define SEAM(k) do { if (IN(k) && IN((k) + 1)) { xcd_barrier(bar); xcd_barrier(bar); xcd_barrier(bar); } } while (0)
#else
#define SEAM(k) do { if (IN(k) && IN((k) + 1)) xcd_barrier(bar); } while (0)
#endif
    if (args.ph_lo < 0) grid.sync();
    if (tid < 16) ((LAS unsigned*)(lds + 131072))[tid] = 0u;
    __syncthreads();
    XcdBarrier bar = xcd_barrier_post((unsigned*)ws, (volatile LAS unsigned*)(lds + 131072) + 8);

#ifndef NO_P0
    if (IN(0))
_Pragma("unroll 1")
    for (int rep = 0; rep < REP_P0; ++rep) {
        const int gw = bx * 8 + wave, NGW = G * 8;
        {
            LAS float* T = (LAS float*)lds;
            constexpr int I_AIN = 16 * (A_IN / 256), I_OUT = 16 * 4, I_BIN = 16 * (B_IN / 256);
            constexpr int PER_PAIR = I_AIN + I_OUT + I_BIN + I_OUT;
            int tid_ = threadIdx.x; asm volatile("" : "+v"(tid_));
            for (int it = bx; it < 2 * PER_PAIR; it += G) {
                const int sl = it / PER_PAIR; int rr = it % PER_PAIR;
                if (rr < I_AIN) { transpose_block(a_w_in + (size_t)sl * DM * A_IN, DM, A_IN, (bf16_t*)(ws + WS_WAIN) + (size_t)sl * DM * A_IN, 1, norm_g + (2 * sl) * DM, T, rr, tid_, false); continue; } rr -= I_AIN;
                if (rr < I_OUT) { transpose_block(a_w_out + (size_t)sl * DM * DM, DM, DM, (bf16_t*)(ws + WS_WAOUT) + (size_t)sl * DM * DM, 0, nullptr, T, rr, tid_, true); continue; } rr -= I_OUT;
                if (rr < I_BIN) { transpose_block(b_w_in + (size_t)sl * DM * B_IN, DM, B_IN, (bf16_t*)(ws + WS_WBIN) + (size_t)sl * DM * B_IN, 2, norm_g + (2 * sl + 1) * DM, T, rr, tid_, false); continue; } rr -= I_BIN;
                transpose_block(b_w_out + (size_t)sl * DM * DM, DM, DM, (bf16_t*)(ws + WS_WBOUT) + (size_t)sl * DM * DM, 0, nullptr, T, rr, tid_, false);
            }
        }
        for (int idx = bx * 512 + tid; idx < SEQ * 32; idx += G * 512) {
            const int t = idx >> 5, f = idx & 31;
            const float inv_freq = __builtin_amdgcn_exp2f(-(float)f * (13.287712379549449f / 32.f));
            const float ang = (float)t * inv_freq;
            double rv = (double)ang * 0.15915494309189535; rv -= __builtin_rint(rv);
            const float fr = (float)rv;
            cosT[idx] = __builtin_amdgcn_cosf(fr); sinT[idx] = __builtin_amdgcn_sinf(fr);
        }
        for (int m0 = gw; m0 < MTOK; m0 += 4 * NGW) {
            v4f v[4][4]; float s[4];
#pragma unroll
            for (int q = 0; q < 4; ++q) { const int m = m0 + q * NGW; if (m < MTOK) { const v4f* xr = (const v4f*)(x_in + (size_t)m * DM) + lane;
#pragma unroll
                for (int j = 0; j < 4; ++j) v[q][j] = __builtin_nontemporal_load(xr + 64 * j); } }
#pragma unroll
            for (int q = 0; q < 4; ++q) { const int m = m0 + q * NGW; if (m < MTOK) {
                s[q] = 0.f;
#pragma unroll
                for (int j = 0; j < 4; ++j) s[q] += (v[q][j][0] * v[q][j][0] + v[q][j][1] * v[q][j][1]) + (v[q][j][2] * v[q][j][2] + v[q][j][3] * v[q][j][3]);
#pragma unroll
                for (int o = 1; o < 64; o <<= 1) s[q] += __shfl_xor(s[q], o);
                v2u* o8 = (v2u*)(XB + (size_t)m * DM) + lane;
#pragma unroll
                for (int j = 0; j < 4; ++j) { v2u w; w.x = pk_bf16(v[q][j][0], v[q][j][1]); w.y = pk_bf16(v[q][j][2], v[q][j][3]); o8[64 * j] = w; }
                if (lane < 16) ss[(size_t)m * 16 + lane] = (lane == 0) ? s[q] : 0.f; } }
        }
    }
#endif
    SEAM(0);

#pragma unroll 1
    for (int L = 0; L < 4; ++L) {
        const int sl = L >> 1, p0 = 1 + 3 * L;
        if ((L & 1) == 0) {
            if (IN(p0)) {
                pg8::Gemm g{XB, (const bf16_t*)(ws + WS_WAIN) + (size_t)sl * DM * A_IN, MTOK, A_IN, DM};
                pg8::StaticOrder S; S.init(MTOK, A_IN, G, bx);
                const pg8::RstdTab rt = rstd_table_fill(S, (LAS float*)(lds + 131072 + 256), ss);
                pg8::EpiAin E{QB, KB, VB, GB, rt, a_qn + sl * 64, a_kn + sl * 64, cosT, sinT};
#ifndef NO_AIN
_Pragma("unroll 1")
                for (int rep = 0; rep < REP_AIN; ++rep) pg8::gemm_phase<pg8::EpiAin, pg8::StaticOrder, GEMM_ALIGN, GEMM_SP2>(lds, g, S, E);
#endif
            }
            SEAM(p0);
            if (IN(p0 + 1)) {
                float mq = fabsf(a_qn[sl * 64 + lane]), mk = fabsf(a_kn[sl * 64 + lane]);
#pragma unroll
                for (int o = 1; o < 64; o <<= 1) { mq = fmaxf(mq, __shfl_xor(mq, o)); mk = fmaxf(mk, __shfl_xor(mk, o)); }
                const float shift2 = 11.7f * mq * mk;
#ifndef NO_ATTN
_Pragma("unroll 1")
                for (int rep = 0; rep < REP_ATTN; ++rep) attn_phase(lds, QB, KB, VB, GB, OGB, a_sink + sl * 16, shift2, (G % 8 == 0) ? (bx % 8) * (G / 8) + bx / 8 : bx, G);
#endif
            }
            SEAM(p0 + 1);
            if (IN(p0 + 2)) {
                pg8::Gemm g{OGB, (const bf16_t*)(ws + WS_WAOUT) + (size_t)sl * DM * DM, MTOK, DM, DM};
                pg8::StaticOrder S; S.init(MTOK, DM, G, bx);
                pg8::EpiOut E{XB, ss, (L == 3) ? out : nullptr};
                if (REP_OUTX) { pg8::EpiOut E2{QB, (float*)(ws + WS_K), nullptr};
_Pragma("unroll 1")
                    for (int rep = 0; rep < REP_OUTX; ++rep) pg8::gemm_phase<pg8::EpiOut, pg8::StaticOrder, GEMM_ALIGN, GEMM_SP2>(lds, g, S, E2); }
#ifndef NO_OUT
_Pragma("unroll 1")
                for (int rep = 0; rep < ((L == 0) ? REP_AOUT0 : 1); ++rep) pg8::gemm_phase<pg8::EpiOut, pg8::StaticOrder, GEMM_ALIGN, GEMM_SP2, OUT_A_AUX>(lds, g, S, E);
#endif
            }
            SEAM(p0 + 2);
        } else {
            if (IN(p0)) {
                pg8::Gemm g{XB, (const bf16_t*)(ws + WS_WBIN) + (size_t)sl * DM * B_IN, MTOK, B_IN, DM};
                pg8::StaticOrder S; S.init(MTOK, B_IN, G, bx);
                const pg8::RstdTab rt = rstd_table_fill(S, (LAS float*)(lds + 131072 + 256), ss);
                pg8::EpiBin E{OGB, KB, KB + (size_t)1024 * 1024, rt, b_conv + sl * 3 * DM, (float*)(ws + WS_V)};
#ifndef NO_BIN
_Pragma("unroll 1")
                for (int rep = 0; rep < REP_BIN; ++rep) pg8::gemm_phase<pg8::EpiBin, pg8::StaticOrder, GEMM_ALIGN, GEMM_SP2>(lds, g, S, E);
#endif
            }
            SEAM(p0);
            if (IN(p0 + 2)) {
                pg8::Gemm g{OGB, (const bf16_t*)(ws + WS_WBOUT) + (size_t)sl * DM * DM, MTOK, DM, DM};
                pg8::StaticOrder S; S.init(MTOK, DM, G, bx);
                conv_fix_tiles(S, OGB, (const float*)(ws + WS_V), KB, KB + (size_t)1024 * 1024);
                pg8::EpiOut E{XB, ss, (L == 3) ? out : nullptr};
                if (REP_OUTX) { pg8::EpiOut E2{QB, (float*)(ws + WS_K), nullptr};
_Pragma("unroll 1")
                    for (int rep = 0; rep < REP_OUTX; ++rep) pg8::gemm_phase<pg8::EpiOut, pg8::StaticOrder, GEMM_ALIGN, GEMM_SP2>(lds, g, S, E2); }
#ifndef NO_OUT
                pg8::gemm_phase<pg8::EpiOut, pg8::StaticOrder, GEMM_ALIGN, GEMM_SP2, OUT_A_AUX>(lds, g, S, E);
#endif
            }
            if (L < 3) SEAM(p0 + 2);
        }
    }
#undef IN
#undef SEAM
}

#ifndef MK_SPLIT
#define MK_SPLIT 0
#endif
extern "C" void kernel_launch(void* const* d_in, const int* in_sizes, int n_in, void* d_out, int out_size, void* d_ws, size_t ws_size, hipStream_t stream) {
    static int grid = 0;
    if (grid == 0) {
        if (n_in != 10 || out_size != MTOK * DM || ws_size < WS_END) { fprintf(stderr, "kernel_launch: unexpected shapes (n_in %d out %d ws %zu)\n", n_in, out_size, ws_size); grid = -1; return; }
        int dev = 0, cus = 0, per_cu = 0;
        hipGetDevice(&dev); hipDeviceGetAttribute(&cus, hipDeviceAttributeMultiprocessorCount, dev);
        hipFuncSetAttribute((const void*)fwd_kernel, hipFuncAttributeMaxDynamicSharedMemorySize, LDS_BYTES);
        if (hipOccupancyMaxActiveBlocksPerMultiprocessor(&per_cu, (const void*)fwd_kernel, 512, LDS_BYTES) != hipSuccess || per_cu < 1) { fprintf(stderr, "kernel_launch: occupancy query says %d\n", per_cu); per_cu = 1; }
        (void)hipGetLastError();
        grid = cus * per_cu;
    }
    if (grid < 0) return;
    if (hipMemsetAsync(d_ws, 0, 16384, stream) != hipSuccess) { fprintf(stderr, "kernel_launch: memset failed\n"); return; }
    Args a{};
    for (int i = 0; i < 10; ++i) a.in[i] = (const float*)d_in[i];
    a.out = (float*)d_out; a.ws = (unsigned char*)d_ws;
#if MK_SPLIT
    for (int p = 0; p < N_PHASES; ++p) { a.ph_lo = p; a.ph_hi = p + 1; hipLaunchKernelGGL(fwd_kernel, dim3(grid), dim3(512), LDS_BYTES, stream, a); }
#else
    a.ph_lo = 0; a.ph_hi = N_PHASES;
    void* kargs[] = {&a};
    hipError_t e = hipLaunchCooperativeKernel((const void*)fwd_kernel, dim3(grid), dim3(512), kargs, LDS_BYTES, stream);
    if (e != hipSuccess) fprintf(stderr, "cooperative launch failed: %s (grid %d)\n", hipGetErrorString(e), grid);
#endif
}
```
